# Optimizing an MI355X kernel written in HIP

```python
import jax, jax.numpy as jnp
from jax import lax
import numpy as np

D_MODEL = 4096
BATCH = 4
SEQ = 2048
DEPTH = 1

RET_HEADS = 8
RET_HEAD_DIM = 256
RET_WIDTH = RET_HEADS * RET_HEAD_DIM
RET_CHUNK = 128
ROPE_BASE = 10000.0
ATTN_GROUPS = ((128, 1), (512, 4), (2048, 16))
ATTN_HEADS_PER_GROUP = 4
ATTN_HEAD_DIM = 128
ATTN_WIDTH = len(ATTN_GROUPS) * ATTN_HEADS_PER_GROUP * ATTN_HEAD_DIM
ATTN_OUT_WIDTH = ATTN_HEADS_PER_GROUP * ATTN_HEAD_DIM
D_FF = 11008
EPS = 1e-6
NEG_INF = -1e30

IN_SIZES = (RET_WIDTH, RET_WIDTH, RET_WIDTH, RET_WIDTH,
            ATTN_WIDTH, ATTN_WIDTH, ATTN_WIDTH,
            D_MODEL, D_MODEL)
IN_WIDTH = sum(IN_SIZES)
IN_SPLITS = tuple(int(s) for s in np.cumsum(IN_SIZES)[:-1])

kernel_name = "hybrid_retention_dilated_attn_macaron"


def rmsnorm(x, g):
    x32 = x.astype(jnp.float32)
    y = x32 * lax.rsqrt(jnp.mean(x32 * x32, axis=-1, keepdims=True) + EPS)
    return (y * g.astype(jnp.float32)).astype(x.dtype)


def swiglu(h, w_gate, w_up, w_down):
    return (jax.nn.silu(h @ w_gate) * (h @ w_up)) @ w_down


def rotary(x):
    S, d = x.shape[1], x.shape[-1]
    pos = jnp.arange(S, dtype=jnp.float32)
    inv_freq = ROPE_BASE ** (-jnp.arange(0, d, 2, dtype=jnp.float32) / d)
    ang = pos[:, None] * inv_freq[None, :]
    cos, sin = jnp.cos(ang)[None, :, None, :], jnp.sin(ang)[None, :, None, :]
    x32 = x.astype(jnp.float32)
    x1, x2 = x32[..., : d // 2], x32[..., d // 2:]
    return jnp.concatenate([x1 * cos - x2 * sin, x2 * cos + x1 * sin], axis=-1)


def retention_chunkwise(q, k, v):
    B_, S, H, dk = q.shape
    dv = v.shape[-1]
    C = RET_CHUNK
    nc = S // C
    log_g = jnp.log(1.0 - 2.0 ** (-5.0 - jnp.arange(H, dtype=jnp.float32)))
    idx = jnp.arange(C, dtype=jnp.float32)
    diff = idx[:, None] - idx[None, :]
    decay_in = jnp.where(diff >= 0, jnp.exp(log_g[:, None, None] * jnp.maximum(diff, 0.0)), 0.0)
    xi = jnp.exp(log_g[:, None] * (idx + 1.0))[None, None]
    zeta = jnp.exp(log_g[:, None] * (C - 1.0 - idx))
    g_chunk = jnp.exp(log_g * C)
    qc = q.astype(jnp.float32).reshape(B_, nc, C, H, dk)
    kc = k.astype(jnp.float32).reshape(B_, nc, C, H, dk) * (dk ** -0.5)
    vc = v.astype(jnp.float32).reshape(B_, nc, C, H, dv)
    scores = jnp.einsum('bnihd,bnjhd->bnhij', qc, kc) * decay_in[None, None]
    y_inner = jnp.einsum('bnhij,bnjhe->bnihe', scores, vc)
    kv = jnp.einsum('bnjhd,hj,bnjhe->bnhde', kc, zeta, vc)

    def step(R, kv_n):
        return R * g_chunk[None, :, None, None] + kv_n, R

    _, R_prev = lax.scan(step, jnp.zeros((B_, H, dk, dv), jnp.float32), jnp.moveaxis(kv, 1, 0))
    R_prev = jnp.moveaxis(R_prev, 0, 1)
    y_cross = jnp.einsum('bnihd,bnhde->bnihe', qc * jnp.moveaxis(xi, 3, 2)[..., None].squeeze(-1)[..., None] if False else qc * jnp.transpose(xi, (0, 1, 3, 2))[..., None], R_prev)
    return (y_inner + y_cross).reshape(B_, S, H, dv)


def dilated_group_attention(q, k, v, window, dilation):
    B_, S, Hg, dh = q.shape
    r = dilation
    L = window // dilation
    U = S // r
    nb = -(-U // L)
    Up = nb * L

    def to_classes(t):
        t = t.astype(jnp.float32).reshape(B_, U, r, Hg, dh).transpose(0, 2, 3, 1, 4)
        t = jnp.pad(t, ((0, 0), (0, 0), (0, 0), (0, Up - U), (0, 0)))
        return t.reshape(B_, r, Hg, nb, L, dh)

    qb, kb, vb = to_classes(q), to_classes(k), to_classes(v)

    def with_prev(t):
        prev = jnp.pad(t, ((0, 0), (0, 0), (0, 0), (1, 0), (0, 0), (0, 0)))[:, :, :, :-1]
        return jnp.concatenate([prev, t], axis=4)

    kw, vw = with_prev(kb), with_prev(vb)
    s = jnp.einsum('brhnid,brhnjd->brhnij', qb, kw) * (dh ** -0.5)
    i = jnp.arange(L)[:, None]
    j = jnp.arange(2 * L)[None, :]
    dist = i + L - j
    band = (dist >= 0) & (dist <= L)
    not_before_start = (jnp.arange(nb)[:, None, None] > 0) | (j[None] >= L)
    mask = band[None] & not_before_start
    s = jnp.where(mask, s, NEG_INF)
    m = jnp.max(s, axis=-1, keepdims=True)
    p = jnp.exp(s - m)
    den = jnp.sum(p, axis=-1)
    o = jnp.einsum('brhnij,brhnjd->brhnid', p, vw) / den[..., None]
    lse = m[..., 0] + jnp.log(den)
    o = o.reshape(B_, r, Hg, Up, dh)[:, :, :, :U].transpose(0, 3, 1, 2, 4).reshape(B_, S, Hg, dh)
    lse = lse.reshape(B_, r, Hg, Up)[..., :U].transpose(0, 3, 1, 2).reshape(B_, S, Hg)
    return o, lse


def dilated_attention(q, k, v):
    B_, S, _ = q.shape
    n_heads = len(ATTN_GROUPS) * ATTN_HEADS_PER_GROUP
    q = q.reshape(B_, S, n_heads, ATTN_HEAD_DIM)
    k = k.reshape(B_, S, n_heads, ATTN_HEAD_DIM)
    v = v.reshape(B_, S, n_heads, ATTN_HEAD_DIM)
    outs, lses = [], []
    for gi, (window, dilation) in enumerate(ATTN_GROUPS):
        sl = slice(gi * ATTN_HEADS_PER_GROUP, (gi + 1) * ATTN_HEADS_PER_GROUP)
        o, lse = dilated_group_attention(q[:, :, sl], k[:, :, sl], v[:, :, sl], window, dilation)
        outs.append(o)
        lses.append(lse)
    o = jnp.stack(outs, axis=0)
    alpha = jax.nn.softmax(jnp.stack(lses, axis=0), axis=0)
    y = jnp.sum(alpha[..., None] * o, axis=0)
    return y.reshape(B_, S, ATTN_OUT_WIDTH)


def head_rms(y):
    return y * lax.rsqrt(jnp.mean(y * y, axis=-1, keepdims=True) + EPS)


def setup_inputs(seed: int = 0) -> dict:
    key = jax.random.key(seed)
    ks = jax.random.split(key, 16)
    nrm = lambda k, shape, fan_in: jax.random.normal(k, shape, jnp.float32) * (fan_in ** -0.5)
    gain = lambda k: 1.0 + 0.05 * jax.random.normal(k, (DEPTH, D_MODEL), jnp.float32)
    return {
        "x": jax.random.normal(ks[0], (BATCH, SEQ, D_MODEL), jnp.float32),
        "ffn1_norm": gain(ks[1]),
        "ffn1_w_gate": nrm(ks[2], (DEPTH, D_MODEL, D_FF), D_MODEL),
        "ffn1_w_up": nrm(ks[3], (DEPTH, D_MODEL, D_FF), D_MODEL),
        "ffn1_w_down": nrm(ks[4], (DEPTH, D_FF, D_MODEL), D_FF),
        "mix_norm": gain(ks[5]),
        "w_in": nrm(ks[6], (DEPTH, D_MODEL, IN_WIDTH), D_MODEL),
        "w_out_ret": nrm(ks[7], (DEPTH, RET_WIDTH, D_MODEL), RET_WIDTH),
        "w_out_attn": nrm(ks[8], (DEPTH, ATTN_OUT_WIDTH, D_MODEL), ATTN_OUT_WIDTH),
        "w_out": nrm(ks[9], (DEPTH, D_MODEL, D_MODEL), D_MODEL),
        "ffn2_norm": gain(ks[10]),
        "ffn2_w_gate": nrm(ks[11], (DEPTH, D_MODEL, D_FF), D_MODEL),
        "ffn2_w_up": nrm(ks[12], (DEPTH, D_MODEL, D_FF), D_MODEL),
        "ffn2_w_down": nrm(ks[13], (DEPTH, D_FF, D_MODEL), D_FF),
        "final_norm": 1.0 + 0.05 * jax.random.normal(ks[14], (D_MODEL,), jnp.float32),
    }


def reference(x, ffn1_norm, ffn1_w_gate, ffn1_w_up, ffn1_w_down, mix_norm, w_in,
              w_out_ret, w_out_attn, w_out, ffn2_norm, ffn2_w_gate, ffn2_w_up, ffn2_w_down,
              final_norm):
    B_, S, _ = x.shape
    for l in range(DEPTH):
        x = x + 0.5 * swiglu(rmsnorm(x, ffn1_norm[l]), ffn1_w_gate[l], ffn1_w_up[l], ffn1_w_down[l])
        h = rmsnorm(x, mix_norm[l])
        q_r, k_r, v_r, g_r, q_a, k_a, v_a, u_ret, u_attn = jnp.split(h @ w_in[l], IN_SPLITS, axis=-1)
        q_r = rotary(q_r.reshape(B_, S, RET_HEADS, RET_HEAD_DIM))
        k_r = rotary(k_r.reshape(B_, S, RET_HEADS, RET_HEAD_DIM))
        y_ret = head_rms(retention_chunkwise(q_r, k_r, v_r.reshape(B_, S, RET_HEADS, RET_HEAD_DIM)))
        y_ret = (jax.nn.silu(g_r.astype(jnp.float32)) * y_ret.reshape(B_, S, RET_WIDTH)).astype(x.dtype)
        y_ret = y_ret @ w_out_ret[l]
        y_attn = dilated_attention(q_a, k_a, v_a).astype(x.dtype) @ w_out_attn[l]
        merged = jax.nn.sigmoid(u_ret) * y_ret + jax.nn.sigmoid(u_attn) * y_attn
        x = x + merged @ w_out[l]
        x = x + 0.5 * swiglu(rmsnorm(x, ffn2_norm[l]), ffn2_w_gate[l], ffn2_w_up[l], ffn2_w_down[l])
    return rmsnorm(x, final_norm)
```

```cpp
#include <hip/hip_runtime.h>
#include <cstdio>
#include <cstdint>
namespace pg8 {
#define PG8_LAS __attribute__((address_space(3)))
typedef unsigned short bf16_t;
typedef short bf16x8 __attribute__((ext_vector_type(8)));
typedef float f32x4 __attribute__((ext_vector_type(4)));
typedef unsigned u32x4 __attribute__((ext_vector_type(4)));
constexpr int BM = 256, BK = 64, HALF = 128, HTB = HALF * BK * 2  , STAGE_BYTES = 8 * HTB, NXCD = 8, WGM = 8;

__host__ __device__ __forceinline__ int lds_byte(int r, int c) { const int st = (r >> 4) * 2 + (c >> 5), rr = r & 15, cc = c & 31, ob = rr * 64 + cc * 2; return st * 1024 + (ob ^ (((ob >> 9) & 1) << 5)); }
__host__ __device__ __forceinline__ void stage_rc(int b, int& R, int& C) { const int st = b / 1024, sb = b % 1024, swz = sb ^ (((sb >> 9) & 1) << 5); R = (st >> 1) * 16 + swz / 64; C = (st & 1) * 32 + (swz % 64) / 2; }
__host__ __device__ __forceinline__ int perm32(int rho) { const int n = rho >> 4, i = rho & 15; return 8 * (i >> 2) + 4 * n + (i & 3); }

struct Unit { int pm, pn; };
struct Gemm { const bf16_t* A; const bf16_t* Bt; int M, N, K; };

struct StaticOrder {
    int nM, nN, nwg, G, c;
    __host__ __device__ void init(int M, int N, int G_, int c_) { nM = M / BM; nN = N / BM; nwg = nM * nN; G = G_; c = c_; }
    __host__ __device__ bool next(int i, Unit& u) const {
        const long L = (long)i * G + c; if (L >= nwg) return false;
        int wgid = (int)L; { const int q = nwg / NXCD, r = nwg % NXCD, xcd = wgid % NXCD, off = wgid / NXCD; wgid = (xcd < r ? xcd * (q + 1) : r * (q + 1) + (xcd - r) * q) + off; }
        const int nig = WGM * nN, gid = wgid / nig, fm = gid * WGM, gsz = (nM - fm) < WGM ? (nM - fm) : WGM;
        u.pm = fm + ((wgid % nig) % gsz); u.pn = (wgid % nig) / gsz; return true;
    }
    __device__ __forceinline__ void a_ready(const Unit&) const {}
    __device__ __forceinline__ void done(const Unit&) const {}
};

__device__ __forceinline__ unsigned cvt_pk_bf16(float lo, float hi) { unsigned r; asm volatile("v_cvt_pk_bf16_f32 %0, %1, %2" : "=v"(r) : "v"(lo), "v"(hi)); return r; }
typedef float f32x2 __attribute__((ext_vector_type(2)));
typedef unsigned u32x2 __attribute__((ext_vector_type(2)));
__host__ __device__ __forceinline__ size_t tofs(int r, int k, int K) { return ((size_t)(r >> 8) * (size_t)(K >> 6) + (size_t)(k >> 6)) * 16384 + (size_t)((r & 255) * 64 + (k & 63)); }
__device__ __forceinline__ float sigm(float v) { return __builtin_amdgcn_rcpf(1.0f + __builtin_amdgcn_exp2f(-1.4426950408889634f * v)); }
__device__ __forceinline__ f32x4 sigm4(f32x4 v) { return (f32x4){sigm(v[0]), sigm(v[1]), sigm(v[2]), sigm(v[3])}; }
__device__ __forceinline__ f32x4 bfx4_lo(u32x4 w) { return (f32x4){__uint_as_float(w.x << 16), __uint_as_float(w.x & 0xffff0000u), __uint_as_float(w.y << 16), __uint_as_float(w.y & 0xffff0000u)}; }
__device__ __forceinline__ f32x4 bfx4_hi(u32x4 w) { return (f32x4){__uint_as_float(w.z << 16), __uint_as_float(w.z & 0xffff0000u), __uint_as_float(w.w << 16), __uint_as_float(w.w & 0xffff0000u)}; }
__device__ __forceinline__ u32x4 pack8(f32x4 a, f32x4 b) { u32x4 w; w.x = cvt_pk_bf16(a[0], a[1]); w.y = cvt_pk_bf16(a[2], a[3]); w.z = cvt_pk_bf16(b[0], b[1]); w.w = cvt_pk_bf16(b[2], b[3]); return w; }

struct EpiSwiGLU {
    static constexpr bool PERM = true, AFTER_DRAIN = false;
    bf16_t* H; int ldh; const float* rstd;
    __device__ __forceinline__ void operator()(const f32x4 (&acc)[2][2][4][2], const Unit& u, int wr, int wc, int fr, int fq) const {
        const int row0 = u.pm * BM + wr * 64 + fr, col0 = u.pn * HALF + wc * 32 + 8 * fq;
#pragma unroll
        for (int ai = 0; ai < 2; ++ai)
#pragma unroll
            for (int m = 0; m < 4; ++m) { const int row = row0 + ai * HALF + m * 16; const float rs = rstd[row];
                const f32x4 g0 = acc[ai][0][m][0] * rs, g1 = acc[ai][0][m][1] * rs, u0 = acc[ai][1][m][0] * rs, u1 = acc[ai][1][m][1] * rs;
                const f32x4 h0 = g0 * sigm4(g0) * u0, h1 = g1 * sigm4(g1) * u1;
                *(u32x4*)(H + tofs(row, col0, ldh)) = pack8(h0, h1); }
    }
};
template <bool BASE_BF16> struct EpiResid {
    static constexpr bool PERM = false, AFTER_DRAIN = false;
    const void* base; float* out; bf16_t* xb; float* part; int ldc; float scale;
    __device__ __forceinline__ void operator()(const f32x4 (&acc)[2][2][4][2], const Unit& u, int wr, int wc, int fr, int fq) const {
        const int row0 = u.pm * BM + wr * 64 + fr, col0 = u.pn * BM + wc * 32 + 4 * fq;
#pragma unroll
        for (int ai = 0; ai < 2; ++ai)
#pragma unroll
            for (int m = 0; m < 4; ++m) { const int row = row0 + ai * HALF + m * 16; const size_t off = (size_t)row * ldc + col0; float ss = 0.f;
#pragma unroll
                for (int bj = 0; bj < 2; ++bj)
#pragma unroll
                    for (int n = 0; n < 2; ++n) { const size_t tof = tofs(row, col0 + bj * HALF + n * 16, ldc); f32x4 b;
                        if (BASE_BF16) { const u32x2 w = *(const u32x2*)((const bf16_t*)base + tof); b = (f32x4){__uint_as_float(w.x << 16), __uint_as_float(w.x & 0xffff0000u), __uint_as_float(w.y << 16), __uint_as_float(w.y & 0xffff0000u)}; }
                        else b = *(const f32x4*)((const float*)base + off + bj * HALF + n * 16);
                        const f32x4 v = b + acc[ai][bj][m][n] * scale;
                        if (out) *(f32x4*)(out + off + bj * HALF + n * 16) = v;
                        ss += (v[0] * v[0] + v[1] * v[1]) + (v[2] * v[2] + v[3] * v[3]);
                        if (xb) { u32x2 w; w.x = cvt_pk_bf16(v[0], v[1]); w.y = cvt_pk_bf16(v[2], v[3]); *(u32x2*)(xb + tof) = w; } }
                ss += __shfl_xor(ss, 16); ss += __shfl_xor(ss, 32);
                if (fq == 0) part[(size_t)row * 64 + u.pn * 4 + wc] = ss; }
    }
};
struct EpiInProj {
    static constexpr bool PERM = true, AFTER_DRAIN = false;
    bf16_t* P; int ldp; const float* rstd; const float* ropec; const float* ropes;
    __device__ __forceinline__ void operator()(const f32x4 (&acc)[2][2][4][2], const Unit& u, int wr, int wc, int fr, int fq) const {
        const int row0 = u.pm * BM + wr * 64 + fr, d0 = wc * 32 + 8 * fq, col0 = u.pn * BM + d0; const int pn = u.pn;
#pragma unroll
        for (int ai = 0; ai < 2; ++ai)
#pragma unroll
            for (int m = 0; m < 4; ++m) { const int row = row0 + ai * HALF + m * 16; const float rs = rstd[row];
                f32x4 a0 = acc[ai][0][m][0] * rs, a1 = acc[ai][0][m][1] * rs, b0 = acc[ai][1][m][0] * rs, b1 = acc[ai][1][m][1] * rs;
                if (pn < 16) { const int pos = row & 2047; const float* cp = ropec + pos * 128 + d0; const float* sp = ropes + pos * 128 + d0;
                    const f32x4 c0 = *(const f32x4*)cp, c1 = *(const f32x4*)(cp + 4), s0 = *(const f32x4*)sp, s1 = *(const f32x4*)(sp + 4);
                    const float sc = pn < 8 ? 1.0f : 0.0625f;
                    const f32x4 x0 = (a0 * c0 - b0 * s0) * sc, x1 = (a1 * c1 - b1 * s1) * sc, y0 = (b0 * c0 + a0 * s0) * sc, y1 = (b1 * c1 + a1 * s1) * sc;
                    a0 = x0; a1 = x1; b0 = y0; b1 = y1; }
                else if (pn < 24) { }
                else if (pn < 32) { a0 = a0 * sigm4(a0); a1 = a1 * sigm4(a1); b0 = b0 * sigm4(b0); b1 = b1 * sigm4(b1); }
                else if (pn < 38) { const float sc = 0.12751743082459868f; a0 = a0 * sc; a1 = a1 * sc; b0 = b0 * sc; b1 = b1 * sc; }
                else if (pn < 50) { }
                else { a0 = sigm4(a0); a1 = sigm4(a1); b0 = sigm4(b0); b1 = sigm4(b1); }
                bf16_t* rowp = P + (size_t)row * ldp + col0;
                *(u32x4*)rowp = pack8(a0, a1); *(u32x4*)(rowp + HALF) = pack8(b0, b1); }
    }
};
struct EpiGateB {
    static constexpr bool PERM = true, AFTER_DRAIN = false;
    const bf16_t* G; int ldg; bf16_t* T; int ldt;
    __device__ __forceinline__ void operator()(const f32x4 (&acc)[2][2][4][2], const Unit& u, int wr, int wc, int fr, int fq) const {
        const int row0 = u.pm * BM + wr * 64 + fr, col0 = u.pn * BM + wc * 32 + 8 * fq;
#pragma unroll
        for (int ai = 0; ai < 2; ++ai)
#pragma unroll
            for (int m = 0; m < 4; ++m) { const int row = row0 + ai * HALF + m * 16;
#pragma unroll
                for (int bj = 0; bj < 2; ++bj) { const u32x4 gw = *(const u32x4*)(G + (size_t)row * ldg + col0 + bj * HALF); *(u32x4*)(T + (size_t)row * ldt + col0 + bj * HALF) = pack8(bfx4_lo(gw) * acc[ai][bj][m][0], bfx4_hi(gw) * acc[ai][bj][m][1]); } }
    }
};
struct EpiGateA {
    static constexpr bool PERM = true, AFTER_DRAIN = false;
    const bf16_t* G; int ldg; const bf16_t* T; int ldt; bf16_t* O; int ldo;
    __device__ __forceinline__ void operator()(const f32x4 (&acc)[2][2][4][2], const Unit& u, int wr, int wc, int fr, int fq) const {
        const int row0 = u.pm * BM + wr * 64 + fr, col0 = u.pn * BM + wc * 32 + 8 * fq;
#pragma unroll
        for (int ai = 0; ai < 2; ++ai)
#pragma unroll
            for (int m = 0; m < 4; ++m) { const int row = row0 + ai * HALF + m * 16;
#pragma unroll
                for (int bj = 0; bj < 2; ++bj) { const u32x4 gw = *(const u32x4*)(G + (size_t)row * ldg + col0 + bj * HALF); const u32x4 tw = *(const u32x4*)(T + (size_t)row * ldt + col0 + bj * HALF);
                    const f32x4 t0 = bfx4_lo(tw), t1 = bfx4_hi(tw);
                    *(u32x4*)(O + tofs(row, col0 + bj * HALF, ldo)) = pack8(bfx4_lo(gw) * acc[ai][bj][m][0] + t0, bfx4_hi(gw) * acc[ai][bj][m][1] + t1); } }
    }
};

struct EpiNull {
    static constexpr bool PERM = true, AFTER_DRAIN = false;
    float* sink;
    __device__ __forceinline__ void operator()(const f32x4 (&acc)[2][2][4][2], const Unit& u, int wr, int wc, int fr, int fq) const {
        f32x4 s = (f32x4){0.f, 0.f, 0.f, 0.f};
#pragma unroll
        for (int ai = 0; ai < 2; ++ai)
#pragma unroll
            for (int bj = 0; bj < 2; ++bj)
#pragma unroll
                for (int m = 0; m < 4; ++m)
#pragma unroll
                    for (int n = 0; n < 2; ++n) s += acc[ai][bj][m][n];
        if ((s[0] + s[1]) + (s[2] + s[3]) == 12345.678f) sink[u.pm * 16 + u.pn] = s[0];
    }
};

struct SameUnitOrder {
    __device__ bool next(int i, Unit& u) const { if (i >= 11) return false; u.pm = 0; u.pn = 0; return true; }
    __device__ __forceinline__ void a_ready(const Unit&) const {}
    __device__ __forceinline__ void done(const Unit&) const {}
};
template <class Epi, class Sched, bool ALIGN_EPI = false, bool SP2 = false>
__device__ __forceinline__ void gemm_phase(PG8_LAS unsigned char* lds, const Gemm g, const Sched& S, const Epi& E) {
    const int tid = threadIdx.x, wid = __builtin_amdgcn_readfirstlane(tid >> 6), lane = tid & 63, wr = wid >> 2, wc = wid & 3, fr = lane & 15, fq = lane >> 4;
    const int K = g.K, nt = K / BK;
    unsigned voffA[2], voffB[2];
#pragma unroll
    for (int i = 0; i < 2; ++i) { int R, C; stage_rc(tid * 16 + i * 8192, R, C); const int Rb = Epi::PERM ? ((R & ~31) + perm32(R & 31)) : R;
        voffA[i] = (unsigned)(R * BK + C) * 2u; voffB[i] = (unsigned)(Rb * BK + C) * 2u; }
    const size_t kstep = (size_t)(BM * BK * 2);
    const size_t hstep = (size_t)HALF * BK * 2;
    const size_t tstep = (size_t)BM * K * 2;
    const unsigned ldsw = (unsigned)wid * 1024u;
    const int aoff = lds_byte(wr * 64 + fr, fq * 8), boff = lds_byte(wc * 32 + fr, fq * 8);
#define PG8_SA(b, h) (((b) * 2 + (h)) * HTB)
#define PG8_SB(b, h) ((4 + (b) * 2 + (h)) * HTB)
#define PG8_STAGE(bufoff, gbase, voff) do { _Pragma("unroll") for (int _i = 0; _i < 2; ++_i) \
        __builtin_amdgcn_global_load_lds((const unsigned*)((const char*)(gbase) + (voff)[_i]), (PG8_LAS unsigned*)(lds + (bufoff) + ldsw + _i * 8192), 16, 0, 0); } while (0)
#define PG8_LDA(dst, b, h) do { _Pragma("unroll") for (int m = 0; m < 4; ++m) _Pragma("unroll") for (int k = 0; k < 2; ++k) dst[m][k] = *(const PG8_LAS bf16x8*)(lds + PG8_SA(b, h) + aoff + m * 2048 + k * 1024); } while (0)
#define PG8_LDB(dst, b, h) do { _Pragma("unroll") for (int n = 0; n < 2; ++n) _Pragma("unroll") for (int k = 0; k < 2; ++k) dst[n][k] = *(const PG8_LAS bf16x8*)(lds + PG8_SB(b, h) + boff + n * 2048 + k * 1024); } while (0)
#define PG8_MMA(ai, bj, At, Bt) do { __builtin_amdgcn_s_setprio(1); _Pragma("unroll") for (int m = 0; m < 4; ++m) _Pragma("unroll") for (int n = 0; n < 2; ++n) _Pragma("unroll") for (int k = 0; k < 2; ++k) \
        acc[ai][bj][m][n] = __builtin_amdgcn_mfma_f32_16x16x32_bf16(Bt[n][k], At[m][k], acc[ai][bj][m][n], 0, 0, 0); __builtin_amdgcn_s_setprio(0); } while (0)
#define PG8_WAIT_V(n) asm volatile("s_waitcnt vmcnt(" #n ")" ::: "memory")
#define PG8_WAIT_L(n) asm volatile("s_waitcnt lgkmcnt(" #n ")" ::: "memory")
#define PG8_BAR __builtin_amdgcn_s_barrier()
#define PG8_SCHED __builtin_amdgcn_sched_barrier(0)
    Unit cur, nxt; int ui = 0;
    if (!S.next(0, cur)) return;
    f32x4 acc[2][2][4][2];
#pragma unroll
    for (int a = 0; a < 2; ++a)
#pragma unroll
        for (int b = 0; b < 2; ++b)
#pragma unroll
            for (int m = 0; m < 4; ++m)
#pragma unroll
                for (int n = 0; n < 2; ++n) acc[a][b][m][n] = (f32x4){0.f, 0.f, 0.f, 0.f};
    bf16x8 At[4][2], B0[2][2], B1[2][2];
    const char* cA = (const char*)g.A + (size_t)cur.pm * tstep; const char* cB = (const char*)g.Bt + (size_t)cur.pn * tstep;
    S.a_ready(cur);
    if constexpr (SP2) {
        PG8_STAGE(PG8_SB(0, 0), cB, voffB); PG8_STAGE(PG8_SB(0, 1), cB + hstep, voffB); PG8_STAGE(PG8_SA(0, 0), cA, voffA); PG8_STAGE(PG8_SA(0, 1), cA + hstep, voffA);
        if (wr == 1) PG8_BAR;
        PG8_WAIT_V(2); PG8_BAR;
        PG8_STAGE(PG8_SB(1, 0), cB + kstep, voffB); PG8_STAGE(PG8_SA(1, 0), cA + kstep, voffA); PG8_STAGE(PG8_SB(1, 1), cB + hstep + kstep, voffB);
        PG8_WAIT_V(6); PG8_BAR;
    } else {
        PG8_STAGE(PG8_SB(0, 0), cB, voffB); PG8_STAGE(PG8_SA(0, 0), cA, voffA); PG8_STAGE(PG8_SB(0, 1), cB + hstep, voffB); PG8_STAGE(PG8_SA(0, 1), cA + hstep, voffA);
        if (wr == 1) PG8_BAR;
        PG8_WAIT_V(4); PG8_BAR;
        PG8_STAGE(PG8_SB(1, 0), cB + kstep, voffB); PG8_STAGE(PG8_SA(1, 0), cA + kstep, voffA); PG8_STAGE(PG8_SB(1, 1), cB + hstep + kstep, voffB);
        PG8_WAIT_V(6); PG8_BAR;
    }
    for (;;) {
        const bool has_next = S.next(ui + 1, nxt);
        const char* nA = has_next ? (const char*)g.A + (size_t)nxt.pm * tstep : cA; const char* nB = has_next ? (const char*)g.Bt + (size_t)nxt.pn * tstep : cB;
        for (int t = 0; t < nt; t += 2) {
            const bool last = (t == nt - 2);
            const char* a1 = cA + (size_t)(t + 1) * kstep;
            const char* a2 = last ? nA : cA + (size_t)(t + 2) * kstep; const char* b2 = last ? nB : cB + (size_t)(t + 2) * kstep;
            const char* a3 = a2 + kstep; const char* b3 = b2 + kstep;
            if (last && has_next) S.a_ready(nxt);
            if constexpr (SP2) {
            PG8_LDB(B0, 0, 0); PG8_LDB(B1, 0, 1); PG8_SCHED; PG8_LDA(At, 0, 0); PG8_STAGE(PG8_SA(1, 1), a1 + hstep, voffA);
            PG8_WAIT_V(8); PG8_WAIT_L(0); PG8_BAR; PG8_MMA(0, 0, At, B0); PG8_MMA(0, 1, At, B1); PG8_BAR; PG8_SCHED;
            PG8_LDA(At, 0, 1); PG8_STAGE(PG8_SB(0, 0), b2, voffB); PG8_STAGE(PG8_SB(0, 1), b2 + hstep, voffB); PG8_STAGE(PG8_SA(0, 0), a2, voffA);
            PG8_WAIT_V(8); PG8_WAIT_L(0); PG8_BAR; PG8_MMA(1, 0, At, B0); PG8_MMA(1, 1, At, B1); PG8_BAR; PG8_SCHED;
            PG8_LDB(B0, 1, 0); PG8_LDB(B1, 1, 1); PG8_SCHED; PG8_LDA(At, 1, 0); PG8_STAGE(PG8_SA(0, 1), a2 + hstep, voffA);
            PG8_WAIT_V(8); PG8_WAIT_L(0); PG8_BAR; PG8_MMA(0, 0, At, B0); PG8_MMA(0, 1, At, B1); PG8_BAR; PG8_SCHED;
            PG8_LDA(At, 1, 1); PG8_STAGE(PG8_SB(1, 0), b3, voffB); PG8_STAGE(PG8_SB(1, 1), b3 + hstep, voffB); PG8_STAGE(PG8_SA(1, 0), a3, voffA);
            PG8_WAIT_V(8); PG8_WAIT_L(0); PG8_BAR; PG8_MMA(1, 0, At, B0); PG8_MMA(1, 1, At, B1); PG8_BAR; PG8_SCHED;
            } else {
            PG8_LDB(B0, 0, 0); PG8_SCHED; PG8_LDA(At, 0, 0); PG8_STAGE(PG8_SA(1, 1), a1 + hstep, voffA);
            PG8_WAIT_L(8); PG8_BAR; PG8_WAIT_L(0); PG8_MMA(0, 0, At, B0); PG8_BAR; PG8_SCHED;
            PG8_LDB(B1, 0, 1); PG8_STAGE(PG8_SB(0, 0), b2, voffB);
            PG8_BAR; PG8_WAIT_L(0); PG8_MMA(0, 1, At, B1); PG8_BAR;
            PG8_LDA(At, 0, 1); PG8_STAGE(PG8_SA(0, 0), a2, voffA);
            PG8_BAR; PG8_WAIT_L(0); PG8_MMA(1, 0, At, B0); PG8_BAR; PG8_SCHED;
            PG8_STAGE(PG8_SB(0, 1), b2 + hstep, voffB);
            PG8_WAIT_V(6); PG8_BAR; PG8_MMA(1, 1, At, B1); PG8_BAR;
            PG8_LDB(B0, 1, 0); PG8_SCHED; PG8_LDA(At, 1, 0); PG8_STAGE(PG8_SA(0, 1), a2 + hstep, voffA);
            PG8_WAIT_L(8); PG8_BAR; PG8_WAIT_L(0); PG8_MMA(0, 0, At, B0); PG8_BAR; PG8_SCHED;
            PG8_LDB(B1, 1, 1); PG8_STAGE(PG8_SB(1, 0), b3, voffB);
            PG8_BAR; PG8_WAIT_L(0); PG8_MMA(0, 1, At, B1); PG8_BAR;
            PG8_LDA(At, 1, 1); PG8_STAGE(PG8_SA(1, 0), a3, voffA);
            PG8_BAR; PG8_WAIT_L(0); PG8_MMA(1, 0, At, B0); PG8_BAR; PG8_SCHED;
            PG8_STAGE(PG8_SB(1, 1), b3 + hstep, voffB);
            PG8_WAIT_V(6); PG8_BAR; PG8_MMA(1, 1, At, B1); PG8_BAR;
            }
        }
        if constexpr (ALIGN_EPI) { if (wr == 0) PG8_BAR; }
        if constexpr (!Epi::AFTER_DRAIN) { E(acc, cur, wr, wc, fr, fq); S.done(cur); }
        if (!has_next) break;
#pragma unroll
        for (int a = 0; a < 2; ++a)
#pragma unroll
            for (int b = 0; b < 2; ++b)
#pragma unroll
                for (int m = 0; m < 4; ++m)
#pragma unroll
                    for (int n = 0; n < 2; ++n) acc[a][b][m][n] = (f32x4){0.f, 0.f, 0.f, 0.f};
        cur = nxt; cA = nA; cB = nB; ++ui;
        if constexpr (ALIGN_EPI) { if (wr == 1) PG8_BAR; }
    }
    PG8_WAIT_V(0);
    if constexpr (!ALIGN_EPI) { if (wr == 0) PG8_BAR; }
    PG8_BAR;
    if constexpr (Epi::AFTER_DRAIN) { E.fused(acc, cur, wr, wc, fr, fq, lds, wid, lane); S.done(cur); }
#undef PG8_SA
#undef PG8_SB
#undef PG8_STAGE
#undef PG8_LDA
#undef PG8_LDB
#undef PG8_MMA
#undef PG8_WAIT_V
#undef PG8_WAIT_L
#undef PG8_BAR
#undef PG8_SCHED
}
}
constexpr int NWAVES = 8;
#ifndef MK_PER_PHASE
#define MK_PER_PHASE 0
#endif
#ifndef MK_NAIVE_MIX
#define MK_NAIVE_MIX 0
#endif
#ifndef MK_REPEAT_PHASE
#define MK_REPEAT_PHASE -1
#endif
#ifndef MK_NULL_PROBE
#define MK_NULL_PROBE 0
#endif
#ifndef MK_VAR
#define MK_VAR 0
#endif
constexpr int N_PHASES = 13;

constexpr int BATCH = 4, SEQ = 2048, DM = 4096, M = BATCH * SEQ, DFF = 11008, NGU = 2 * DFF;
constexpr int RW = 2048, RH = 8, RD = 256, AW = 1536, AHT = 12, AD = 128, AOW = 512, NIN = 20992;
constexpr int C_QR = 0, C_KR = 2048, C_VR = 4096, C_GR = 6144, C_QA = 8192, C_KA = 9728, C_VA = 11264, C_UA = 12800, C_UB = 16896;
constexpr float EPS = 1e-6f;

constexpr size_t MiB = 1u << 20;
constexpr size_t WS_CTL = 0, CTL_ZERO_BYTES = 1 * MiB;
constexpr size_t WS_ROPEC = 2 * MiB, WS_ROPES = 3 * MiB;
constexpr size_t WS_RSTD = 4 * MiB;
constexpr size_t WS_PART = 5 * MiB;
constexpr size_t WS_LSE = 7 * MiB;
constexpr size_t WS_WGU1 = 8 * MiB, WS_WD1 = WS_WGU1 + 172 * MiB, WS_WIN = WS_WD1 + 86 * MiB, WS_WOA = WS_WIN + 164 * MiB, WS_WOB = WS_WOA + 16 * MiB,
                 WS_WO = WS_WOB + 4 * MiB, WS_WGU2 = WS_WO + 32 * MiB, WS_WD2 = WS_WGU2 + 172 * MiB;
constexpr size_t WS_XB = WS_WD2 + 86 * MiB;
constexpr size_t WS_P = WS_XB + 64 * MiB;
constexpr size_t WS_H = WS_P;
constexpr size_t WS_YR = WS_P + 328 * MiB;
constexpr size_t WS_OB = WS_YR + 32 * MiB;
constexpr size_t WS_YB = WS_OB + 24 * MiB;
constexpr size_t WS_T = WS_YB + 8 * MiB;
constexpr size_t WS_MG = WS_T + 128 * MiB;
constexpr size_t WS_END = WS_MG + 64 * MiB;
static_assert((size_t)NGU * DM * 2 == 172 * MiB && (size_t)DM * DFF * 2 == 86 * MiB && (size_t)NIN * DM * 2 == 164 * MiB && (size_t)M * NIN * 2 == 328 * MiB && (size_t)M * DFF * 2 == 172 * MiB, "d_ws map");
constexpr int CW_TMO = 0, CW_CODE = 1;
constexpr int CW_BAR = 4096;

constexpr int RING_OFF = 0, RING_BYTES = 131072;
constexpr int LDSCTL_OFF = 139264, MISC_OFF = LDSCTL_OFF + 320;
constexpr int LDS_BYTES = 147456;
static_assert(MISC_OFF + 128 <= LDS_BYTES, "LDS map");

#define GAS __attribute__((address_space(1)))
#define LAS __attribute__((address_space(3)))
typedef unsigned short bf16;
typedef unsigned v4u __attribute__((ext_vector_type(4)));
typedef unsigned v2u __attribute__((ext_vector_type(2)));
typedef float f32x4 __attribute__((ext_vector_type(4)));
typedef short bf16x8 __attribute__((ext_vector_type(8)));
typedef GAS unsigned gu32;
typedef GAS unsigned long long gu64;
#define RLX_AGENT __ATOMIC_RELAXED, __HIP_MEMORY_SCOPE_AGENT
#define LDS_WAIT() asm volatile("s_waitcnt lgkmcnt(0)" ::: "memory")
#define VM_WAIT() asm volatile("s_waitcnt vmcnt(0)" ::: "memory")
__device__ __forceinline__ unsigned f2bf(float f) { unsigned u = __builtin_bit_cast(unsigned, f); return (u + 0x7fffu + ((u >> 16) & 1u)) >> 16; }
__device__ __forceinline__ unsigned pk2(float lo, float hi) { return f2bf(lo) | (f2bf(hi) << 16); }
__device__ __forceinline__ float bf2f(bf16 h) { return __uint_as_float((unsigned)h << 16); }
__device__ __forceinline__ float bflo(unsigned w) { return __uint_as_float(w << 16); }
__device__ __forceinline__ float bfhi(unsigned w) { return __uint_as_float(w & 0xffff0000u); }

#define XB_TMO      128
#define XB_XCNT(j)  (256  + 64 * (j))
#define XB_XSUB(j)  (1280 + 64 * (j))
#define XB_XGEN(j)  (2304 + 64 * (j))
#define XB_TOP      3328
#define XB_TOPGEN   3392
#define XCD_BAR_WORDS 3456
#define XB_SPIN_CAP (1u << 18)

__device__ __forceinline__ unsigned xb_ld(unsigned* p)              { return __hip_atomic_load(p, __ATOMIC_RELAXED, __HIP_MEMORY_SCOPE_AGENT); }
__device__ __forceinline__ unsigned xb_add(unsigned* p, unsigned v) { return __hip_atomic_fetch_add(p, v, __ATOMIC_RELAXED, __HIP_MEMORY_SCOPE_AGENT); }
__device__ __forceinline__ unsigned xb_xcc_id() { return (unsigned)__builtin_amdgcn_s_getreg((3 << 11) | 20) & 0xFu; }
#define XB_SPIN(cond, bar) do { unsigned _sp = 0; while (cond) { __builtin_amdgcn_s_sleep(1); \
    if ((++_sp & 255u) == 0u) { if (xb_ld(&(bar)[XB_TMO])) break; if (_sp > XB_SPIN_CAP) { atomicAdd(&(bar)[XB_TMO], 1u); break; } } } } while (0)

struct XcdBarrier {
    unsigned* bar; unsigned x;
    volatile LAS unsigned* st;
};

__device__ __forceinline__ XcdBarrier xcd_barrier_post(unsigned* bar, volatile LAS unsigned* st) {
    XcdBarrier b; b.bar = bar; b.x = xb_xcc_id(); b.st = st;
    if (threadIdx.x == 0) (void)xb_add(&bar[XB_XCNT(b.x)], 1u);
    return b;
}
__device__ __forceinline__ void xcd_barrier_complete(unsigned* bar, unsigned x, unsigned& nloc, unsigned& nx) {
    const unsigned G = gridDim.x * gridDim.y * gridDim.z;
    unsigned sum, cnt, mine, sp = 0u;
    for (;;) {
        sum = 0u; cnt = 0u; mine = 0u;
#pragma unroll
        for (unsigned j = 0; j < 16; ++j) { const unsigned c = xb_ld(&bar[XB_XCNT(j)]); sum += c; cnt += (c > 0u) ? 1u : 0u; mine = (j == x) ? c : mine; }
        if (sum == G) break;
        __builtin_amdgcn_s_sleep(1);
        if ((++sp & 255u) == 0u) { if (xb_ld(&bar[XB_TMO])) break; if (sp > XB_SPIN_CAP) { atomicAdd(&bar[XB_TMO], 1u); break; } }
    }
    nloc = mine > 0u ? mine : 1u; nx = cnt > 0u ? cnt : 1u;
}

__device__ __forceinline__ void xcd_barrier(const XcdBarrier& b) {
    asm volatile("s_waitcnt vmcnt(0)" ::: "memory");
    __syncthreads();
    if (threadIdx.x == 0) {
        unsigned* bar = b.bar;
        __builtin_amdgcn_s_waitcnt(0);
        unsigned nloc = b.st[0], nx = b.st[1];
        if (nloc == 0u) { xcd_barrier_complete(bar, b.x, nloc, nx); b.st[0] = nloc; b.st[1] = nx; }
        const unsigned old = xb_add(&bar[XB_XSUB(b.x)], 1u);
        const unsigned gen = old / nloc;
        if (old + 1u == (gen + 1u) * nloc) {
            __builtin_amdgcn_fence(__ATOMIC_RELEASE, "agent");
            asm volatile("s_waitcnt vmcnt(0)" ::: "memory");
            const unsigned og = xb_add(&bar[XB_TOP], 1u);
            const unsigned tg = og / nx;
            if (og + 1u == (tg + 1u) * nx) xb_add(&bar[XB_TOPGEN], 1u);
            else XB_SPIN(xb_ld(&bar[XB_TOPGEN]) == tg, bar);
            __builtin_amdgcn_fence(__ATOMIC_ACQUIRE, "agent");
            xb_add(&bar[XB_XGEN(b.x)], 1u);
            asm volatile("s_waitcnt vmcnt(0)" ::: "memory");
        } else {
            XB_SPIN(xb_ld(&bar[XB_XGEN(b.x)]) == gen, bar);
            __builtin_amdgcn_fence(__ATOMIC_ACQUIRE, "agent");
            asm volatile("s_waitcnt vmcnt(0)" ::: "memory");
        }
    }
    __syncthreads();
}
struct Frame {
    LAS unsigned char* lds;
    volatile LAS unsigned* MISC;
    gu32* ctl;
    int tid, lane, wave;
    int vcu, G;
};
__device__ __forceinline__ float wave_sum(float v) {
#pragma unroll
    for (int o = 1; o < 64; o <<= 1) v += __shfl_xor(v, o);
    return v;
}
__device__ __forceinline__ float wave_max(float v) {
#pragma unroll
    for (int o = 1; o < 64; o <<= 1) v = fmaxf(v, __shfl_xor(v, o));
    return v;
}

__device__ __forceinline__ void conv_item(const float* W, int K, int N, const float* gain, bf16* WT, int drow0, int k0, int n0, LAS float* scr, int lane) {
    const int kr = lane >> 4, c4 = lane & 15;
    f32x4 v[16];
#pragma unroll
    for (int i = 0; i < 16; ++i) v[i] = __builtin_nontemporal_load((const GAS f32x4*)(W + (size_t)(k0 + 4 * i + kr) * N + n0 + 4 * c4));
#pragma unroll
    for (int i = 0; i < 16; ++i) { const int k = 4 * i + kr; *(LAS f32x4*)(scr + k * 64 + ((4 * c4) ^ (((k >> 3) & 7) << 2))) = v[i]; }
    LDS_WAIT(); asm volatile("" ::: "memory");
    const int c = lane & 7;
    f32x4 g0 = (f32x4){1.f, 1.f, 1.f, 1.f}, g1 = g0;
    if (gain) { g0 = *(const GAS f32x4*)(gain + k0 + 8 * c); g1 = *(const GAS f32x4*)(gain + k0 + 8 * c + 4); }
#pragma unroll
    for (int j = 0; j < 8; ++j) { const int n = (lane >> 3) + 8 * j; const LAS float* s = scr + (8 * c) * 64 + (n ^ (c << 2));
        v4u o; o.x = pk2(s[0 * 64] * g0[0], s[1 * 64] * g0[1]); o.y = pk2(s[2 * 64] * g0[2], s[3 * 64] * g0[3]); o.z = pk2(s[4 * 64] * g1[0], s[5 * 64] * g1[1]); o.w = pk2(s[6 * 64] * g1[2], s[7 * 64] * g1[3]);
        *(GAS v4u*)(WT + pg8::tofs(drow0 + n, k0 + 8 * c, K)) = o; }
    LDS_WAIT(); asm volatile("" ::: "memory");
}
template <int MODE> __device__ __forceinline__ void conv_matrix(Frame& F, const float* W, int K, int N, const float* gain, bf16* WT, int& base, int wk, int NW) {
    LAS float* scr = (LAS float*)(F.lds + RING_OFF + F.wave * 16384);
    const int nblk = N / 64, nitems = (K / 64) * nblk;
    int it = wk - (base % NW); if (it < 0) it += NW;
    for (; it < nitems; it += NW) { const int kb = it / nblk, nb = it % nblk, n0 = nb * 64;
        const int drow0 = MODE == 0 ? n0 : (256 * (n0 >> 7) + (n0 & 127) + (MODE == 2 ? 128 : 0));
        conv_item(W, K, N, gain, WT, drow0, kb * 64, n0, scr, F.lane); }
    base += nitems;
}
__device__ __forceinline__ void row_to_bf16_rstd(const float* xrow, bf16* XBt, int m, float* rstd_out, int lane) {
    const GAS f32x4* xr = (const GAS f32x4*)xrow + lane;
    f32x4 v[16]; float s = 0.f;
#pragma unroll
    for (int j = 0; j < 16; ++j) { v[j] = xr[64 * j]; s += (v[j].x * v[j].x + v[j].y * v[j].y) + (v[j].z * v[j].z + v[j].w * v[j].w); }
    const float tot = wave_sum(s);
#pragma unroll
    for (int j = 0; j < 16; ++j) { v2u w; w.x = pk2(v[j].x, v[j].y); w.y = pk2(v[j].z, v[j].w); *(GAS v2u*)(XBt + pg8::tofs(m, 256 * j + 4 * lane, DM)) = w; }
    if (lane == 0) *rstd_out = 1.0f / sqrtf(tot * (1.0f / DM) + EPS);
}
struct Ptrs {
    const float* in[15]; float* out; unsigned char* ws;
};
__device__ __forceinline__ void p0_prologue(Frame& F, const Ptrs& A) {
    unsigned char* ws = A.ws;
    int base = 0; const int wk0 = F.vcu * NWAVES + F.wave, NW0 = F.G * NWAVES;
    conv_matrix<1>(F, A.in[2], DM, DFF, A.in[1], (bf16*)(ws + WS_WGU1), base, wk0, NW0);
    conv_matrix<2>(F, A.in[3], DM, DFF, A.in[1], (bf16*)(ws + WS_WGU1), base, wk0, NW0);
    conv_matrix<0>(F, A.in[6], DM, NIN, A.in[5], (bf16*)(ws + WS_WIN), base, wk0, NW0);
    const int gw = F.vcu * NWAVES + F.wave, NGW = F.G * NWAVES;
    for (int m = gw; m < M; m += NGW) row_to_bf16_rstd(A.in[0] + (size_t)m * DM, (bf16*)(ws + WS_XB), m, (float*)(ws + WS_RSTD) + m, F.lane);
    float* rc = (float*)(ws + WS_ROPEC); float* rsn = (float*)(ws + WS_ROPES);
    for (int e = blockIdx.x * (NWAVES * 64) + F.tid; e < SEQ * 128; e += F.G * NWAVES * 64) { const int pos = e >> 7, i = e & 127;
        double p = 1.0, b = 0.930572040929699;
#pragma unroll
        for (int bit = 0; bit < 7; ++bit) { if ((i >> bit) & 1) p *= b; b *= b; }
        const float ang = (float)pos * (float)p;
        double t = (double)ang * 0.15915494309189535; t -= __builtin_rint(t);
        const float r = (float)(t * 6.283185307179586);
        rc[e] = cosf(r); rsn[e] = sinf(r); }
}
template <int JOB> __device__ __forceinline__ void tail_convert(Frame& F, const Ptrs& A, int first) {
    if ((int)blockIdx.x < first) return;
    unsigned char* ws = A.ws; int base = 0; const int wk = ((int)blockIdx.x - first) * NWAVES + F.wave, NW = (F.G - first) * NWAVES;
    if (JOB == 1) conv_matrix<0>(F, A.in[4], DFF, DM, nullptr, (bf16*)(ws + WS_WD1), base, wk, NW);
    if (JOB == 2) { conv_matrix<0>(F, A.in[7], RW, DM, nullptr, (bf16*)(ws + WS_WOA), base, wk, NW);
        conv_matrix<0>(F, A.in[8], AOW, DM, nullptr, (bf16*)(ws + WS_WOB), base, wk, NW);
        conv_matrix<0>(F, A.in[9], DM, DM, nullptr, (bf16*)(ws + WS_WO), base, wk, NW);
        conv_matrix<1>(F, A.in[11], DM, DFF, A.in[10], (bf16*)(ws + WS_WGU2), base, wk, NW);
        conv_matrix<2>(F, A.in[12], DM, DFF, A.in[10], (bf16*)(ws + WS_WGU2), base, wk, NW); }
    if (JOB == 3) conv_matrix<0>(F, A.in[13], DFF, DM, nullptr, (bf16*)(ws + WS_WD2), base, wk, NW);
}
__device__ __forceinline__ void reduce_rstd(Frame& F, const float* part, float* rstd) {
    const int gw = F.vcu * NWAVES + F.wave, NGW = F.G * NWAVES;
    for (int m = gw; m < M; m += NGW) { const float tot = wave_sum(part[(size_t)m * 64 + F.lane]); if (F.lane == 0) rstd[m] = 1.0f / sqrtf(tot * (1.0f / DM) + EPS); }
}
__device__ __forceinline__ void final_norm(Frame& F, float* out, const float* part, const float* gain) {
    const int gw = F.vcu * NWAVES + F.wave, NGW = F.G * NWAVES;
    for (int m = gw; m < M; m += NGW) { const float tot = wave_sum(part[(size_t)m * 64 + F.lane]); const float rs = 1.0f / sqrtf(tot * (1.0f / DM) + EPS);
        GAS f32x4* xr = (GAS f32x4*)(out + (size_t)m * DM) + F.lane; const GAS f32x4* gr = (const GAS f32x4*)gain + F.lane;
        f32x4 v[16];
#pragma unroll
        for (int j = 0; j < 16; ++j) v[j] = xr[64 * j];
#pragma unroll
        for (int j = 0; j < 16; ++j) xr[64 * j] = v[j] * rs * gr[64 * j]; }
}

__device__ __forceinline__ void naive_attn(Frame& F, const bf16* P, bf16* YB) {
    LAS float* qf = (LAS float*)(F.lds);
    LAS float* sc = qf + 384;
    LAS float* red = sc + 400;
    const int t = F.tid;
    for (int uidx = blockIdx.x; uidx < M * 4; uidx += F.G) {
        const int row = uidx >> 2, hi = uidx & 3, b = row >> 11, s = row & 2047;
        if (t < 384) { const int g = t >> 7, d = t & 127; qf[t] = bf2f(P[(size_t)row * NIN + C_QA + (4 * g + hi) * 128 + d]); }
        __syncthreads();
        if (t < 387) { const int g = t / 129, kk = t % 129, r = g == 0 ? 1 : (g == 1 ? 4 : 16), pos = s - kk * r; float a = -1e30f;
            if (pos >= 0) { const bf16* kp = P + (size_t)(b * SEQ + pos) * NIN + C_KA + (4 * g + hi) * 128; a = 0.f;
                for (int d = 0; d < 128; ++d) a += qf[g * 128 + d] * bf2f(kp[d]); }
            sc[t] = a; }
        __syncthreads();
        float mx = -1e30f; for (int k = 0; k < 387; ++k) mx = fmaxf(mx, sc[k]);
        float den = 0.f; for (int k = 0; k < 387; ++k) den += __builtin_amdgcn_exp2f(sc[k] - mx);
        { const int d = t & 127, part = t >> 7; float y = 0.f;
          for (int k = part * 97; k < (part + 1) * 97 && k < 387; ++k) { const int g = k / 129, kk = k % 129, r = g == 0 ? 1 : (g == 1 ? 4 : 16), pos = s - kk * r;
              if (pos >= 0) y += __builtin_amdgcn_exp2f(sc[k] - mx) * bf2f(P[(size_t)(b * SEQ + pos) * NIN + C_VA + (4 * g + hi) * 128 + d]); }
          red[part * 128 + d] = y; }
        __syncthreads();
        if (t < 128) { const float y = (red[t] + red[128 + t]) + (red[256 + t] + red[384 + t]); YB[pg8::tofs(row, hi * 128 + t, AOW)] = (bf16)f2bf(y / den); }
        __syncthreads();
    }
}
__device__ __forceinline__ void naive_ret(Frame& F, const bf16* P, bf16* YR) {
    LAS float* qf = (LAS float*)(F.lds);
    LAS float* sc = qf + 256;
    LAS float* red = sc + 2048;
    LAS float* wsum = red + 512;
    const int t = F.tid;
    for (int uidx = blockIdx.x; uidx < M * RH; uidx += F.G) {
        const int row = uidx >> 3, h = uidx & 7, b = row >> 11, s = row & 2047;
        const float l2g = __builtin_log2f(1.0f - __builtin_amdgcn_exp2f(-5.0f - (float)h));
        if (t < 256) qf[t] = bf2f(P[(size_t)row * NIN + C_QR + h * 256 + t]);
        __syncthreads();
        for (int j = t; j <= s; j += 512) { const bf16* kp = P + (size_t)(b * SEQ + j) * NIN + C_KR + h * 256; float a = 0.f;
            for (int d = 0; d < 256; ++d) a += qf[d] * bf2f(kp[d]);
            sc[j] = a * __builtin_amdgcn_exp2f(l2g * (float)(s - j)); }
        __syncthreads();
        { const int e = t & 255, half = t >> 8; float o = 0.f; const bf16* vp = P + (size_t)(b * SEQ) * NIN + C_VR + h * 256 + e;
          for (int j = half; j <= s; j += 2) o += sc[j] * bf2f(vp[(size_t)j * NIN]);
          red[half * 256 + e] = o; }
        __syncthreads();
        float o = 0.f, ss = 0.f;
        if (t < 256) { o = red[t] + red[256 + t]; ss = o * o; }
        ss = wave_sum(ss); if (F.lane == 0) wsum[F.wave] = ss;
        __syncthreads();
        if (t < 256) { const float tot = (wsum[0] + wsum[1]) + (wsum[2] + wsum[3]); const float rs = 1.0f / sqrtf(tot * (1.0f / 256.0f) + EPS);
            const float gt = bf2f(P[(size_t)row * NIN + C_GR + h * 256 + t]);
            YR[pg8::tofs(row, h * 256 + t, RW)] = (bf16)f2bf(gt * (o * rs)); }
        __syncthreads();
    }
}
typedef short v4i16_t __attribute__((ext_vector_type(4)));
__device__ __forceinline__ bf16x8 tr_pair(const LAS unsigned char* p0, const LAS unsigned char* p1) {
    const v4i16_t lo = __builtin_amdgcn_ds_read_tr16_b64_v4i16((LAS v4i16_t*)p0), hi = __builtin_amdgcn_ds_read_tr16_b64_v4i16((LAS v4i16_t*)p1);
    return __builtin_shufflevector(lo, hi, 0, 1, 2, 3, 4, 5, 6, 7);
}
template <int D> __device__ __forceinline__ unsigned tile_toff(size_t stride, int tid) { constexpr int PPR = D / 8; return (unsigned)((size_t)(tid / PPR) * stride * 2 + (size_t)(tid % PPR) * 16); }
template <int D> __device__ __forceinline__ void tile_load(v4u (&r)[D / 64], const bf16* base, size_t stride, unsigned toff) {
    constexpr int PPR = D / 8;
#pragma unroll
    for (int i = 0; i < D / 64; ++i) r[i] = *(const GAS v4u*)((const char*)base + (size_t)i * (512 / PPR) * stride * 2 + toff);
}
template <int D, int STR> __device__ __forceinline__ void tile_store(LAS unsigned char* buf, const v4u (&r)[D / 64], int tid) {
    constexpr int PPR = D / 8; LAS unsigned char* p0 = buf + (tid / PPR) * STR + (tid % PPR) * 16;
#pragma unroll
    for (int i = 0; i < D / 64; ++i) *(LAS v4u*)(p0 + i * (512 / PPR) * STR) = r[i];
}
template <int DK, int KSTR> __device__ __forceinline__ void st_compute(f32x4 (&st)[4], const LAS unsigned char* Kb, const bf16x8 (&qf)[DK / 32], int lane) {
    const LAS unsigned char* kp = Kb + (lane & 15) * KSTR + (lane >> 4) * 16;
    bf16x8 kf[2][4];
#pragma unroll
    for (int kg = 0; kg < 4; ++kg) { kf[0][kg] = *(const LAS bf16x8*)(kp + kg * 16 * KSTR); st[kg] = (f32x4){0.f, 0.f, 0.f, 0.f}; }
#pragma unroll
    for (int ks = 0; ks < DK / 32; ++ks) {
        if (ks + 1 < DK / 32) {
#pragma unroll
            for (int kg = 0; kg < 4; ++kg) kf[(ks + 1) & 1][kg] = *(const LAS bf16x8*)(kp + kg * 16 * KSTR + (ks + 1) * 64); }
        __builtin_amdgcn_sched_barrier(0);
#pragma unroll
        for (int kg = 0; kg < 4; ++kg) st[kg] = __builtin_amdgcn_mfma_f32_16x16x32_bf16(kf[ks & 1][kg], qf[ks], st[kg], 0, 0, 0);
        __builtin_amdgcn_sched_barrier(0);
    }
}
template <int DV, int VSTR> __device__ __forceinline__ void pv_compute(f32x4 (&of)[DV / 16], const LAS unsigned char* Vb, const f32x4 (&p)[4], int lane) {
    const LAS unsigned char* vp = Vb + (4 * (lane >> 4) + ((lane & 15) >> 2)) * VSTR + (lane & 3) * 8;
    bf16x8 pf[2];
#pragma unroll
    for (int s = 0; s < 2; ++s) { v4u w; w.x = pg8::cvt_pk_bf16(p[2 * s][0], p[2 * s][1]); w.y = pg8::cvt_pk_bf16(p[2 * s][2], p[2 * s][3]); w.z = pg8::cvt_pk_bf16(p[2 * s + 1][0], p[2 * s + 1][1]); w.w = pg8::cvt_pk_bf16(p[2 * s + 1][2], p[2 * s + 1][3]);
        pf[s] = __builtin_bit_cast(bf16x8, w); }
    constexpr int GPS = DV / 64, NB = 2 * GPS;
    bf16x8 vf[2][4];
#pragma unroll
    for (int j = 0; j < 4; ++j) { const LAS unsigned char* a0 = vp + j * 32; vf[0][j] = tr_pair(a0, a0 + 16 * VSTR); }
#pragma unroll
    for (int b = 0; b < NB; ++b) {
        if (b + 1 < NB) { const int s1 = (b + 1) / GPS, g1 = 4 * ((b + 1) % GPS);
#pragma unroll
            for (int j = 0; j < 4; ++j) { const LAS unsigned char* a0 = vp + (32 * s1) * VSTR + (g1 + j) * 32; vf[(b + 1) & 1][j] = tr_pair(a0, a0 + 16 * VSTR); } }
        __builtin_amdgcn_sched_barrier(0);
        const int s = b / GPS, g0 = 4 * (b % GPS);
#pragma unroll
        for (int j = 0; j < 4; ++j) of[g0 + j] = __builtin_amdgcn_mfma_f32_16x16x32_bf16(vf[b & 1][j], pf[s], of[g0 + j], 0, 0, 0);
        __builtin_amdgcn_sched_barrier(0);
    }
}
constexpr int MIX_LDS_BYTES = 2 * (64 * (2 * 256 + 16) + 64 * (2 * 256 + 32));

__device__ __forceinline__ void ret_unit(Frame& F, const bf16* P, bf16* YR, int b, int h, int n) {
    constexpr int KSTR = 2 * RD + 16, VSTR = 2 * RD + 32, KBUF = 64 * KSTR, BUF = KBUF + 64 * VSTR;
    const int lane = F.lane, w = F.wave, kr = lane & 15, quad = lane >> 4, tid = F.tid;
    const float l2g = __builtin_log2f(1.0f - __builtin_amdgcn_exp2f(-5.0f - (float)h));
    const size_t rowq = (size_t)b * SEQ + 128 * n + 16 * w + kr;
    const bf16* kbase = P + (size_t)b * SEQ * NIN + C_KR + h * RD; const bf16* vbase = P + (size_t)b * SEQ * NIN + C_VR + h * RD;
    bf16x8 qf[RD / 32];
#pragma unroll
    for (int ks = 0; ks < RD / 32; ++ks) qf[ks] = *(const GAS bf16x8*)(P + rowq * NIN + C_QR + h * RD + 32 * ks + 8 * quad);
    f32x4 of[RD / 16];
#pragma unroll
    for (int i = 0; i < RD / 16; ++i) of[i] = (f32x4){0.f, 0.f, 0.f, 0.f};
    const int nsc = 2 * (n + 1); const float qi = (float)(128 * n + 16 * w + kr);
    v4u rk[RD / 64], rv[RD / 64];
    const unsigned toff = tile_toff<RD>(NIN, tid);
    tile_load<RD>(rk, kbase, NIN, toff); tile_load<RD>(rv, vbase, NIN, toff);
    tile_store<RD, KSTR>(F.lds, rk, tid); tile_store<RD, VSTR>(F.lds + KBUF, rv, tid);
    __syncthreads();
    for (int sc = 0; sc < nsc; ++sc) {
        const LAS unsigned char* Kb = F.lds + (sc & 1) * BUF; LAS unsigned char* Nb = F.lds + ((sc + 1) & 1) * BUF;
        const bool more = sc + 1 < nsc;
        if (more) { tile_load<RD>(rk, kbase + (size_t)(64 * (sc + 1)) * NIN, NIN, toff); tile_load<RD>(rv, vbase + (size_t)(64 * (sc + 1)) * NIN, NIN, toff); }
        f32x4 st[4];
        st_compute<RD, KSTR>(st, Kb, qf, lane);
        const float d0 = qi - (float)(64 * sc + 4 * quad);
#pragma unroll
        for (int kg = 0; kg < 4; ++kg)
#pragma unroll
            for (int r = 0; r < 4; ++r) { const float d = d0 - (float)(16 * kg + r); st[kg][r] = d >= 0.f ? st[kg][r] * __builtin_amdgcn_exp2f(l2g * d) : 0.f; }
        pv_compute<RD, VSTR>(of, Kb + KBUF, st, lane);
        if (more) { tile_store<RD, KSTR>(Nb, rk, tid); tile_store<RD, VSTR>(Nb + KBUF, rv, tid); }
        __syncthreads();
    }
    float ss = 0.f;
#pragma unroll
    for (int i = 0; i < RD / 16; ++i) ss += (of[i][0] * of[i][0] + of[i][1] * of[i][1]) + (of[i][2] * of[i][2] + of[i][3] * of[i][3]);
    ss += __shfl_xor(ss, 16); ss += __shfl_xor(ss, 32);
    const float rs = 1.0f / sqrtf(ss * (1.0f / RD) + EPS);
    const bf16* gp = P + rowq * NIN + C_GR + h * RD + 4 * quad;
#pragma unroll
    for (int i = 0; i < RD / 16; ++i) { const v2u gw = *(const GAS v2u*)(gp + 16 * i);
        v2u o; o.x = pg8::cvt_pk_bf16(bflo(gw.x) * (of[i][0] * rs), bfhi(gw.x) * (of[i][1] * rs)); o.y = pg8::cvt_pk_bf16(bflo(gw.y) * (of[i][2] * rs), bfhi(gw.y) * (of[i][3] * rs));
        *(GAS v2u*)(YR + pg8::tofs((int)rowq, h * RD + 4 * quad + 16 * i, RW)) = o; }
}
__device__ __forceinline__ void ret_phase(Frame& F, const bf16* P, bf16* YR) {
    for (int up = blockIdx.x; up < BATCH * RH * 8; up += F.G) { const int np = up & 7, h = (up >> 3) & 7, b = up >> 6;
        ret_unit(F, P, YR, b, h, 15 - np); ret_unit(F, P, YR, b, h, np); }
}
__device__ __forceinline__ void attn_unit(Frame& F, const bf16* P, bf16* OB, float* LSE, int b, int g, int hi, int c, int n) {
    constexpr int KSTR = 2 * AD + 16, VSTR = 2 * AD + 32, KBUF = 64 * KSTR, BUF = KBUF + 64 * VSTR;
    const int lane = F.lane, w = F.wave, kr = lane & 15, quad = lane >> 4, tid = F.tid;
    const int r = g == 0 ? 1 : (g == 1 ? 4 : 16), hd = 4 * g + hi;
    const int uq = 128 * n + 16 * w + kr;
    const size_t rowq = (size_t)b * SEQ + (size_t)uq * r + c;
    const int ub0 = n > 0 ? 128 * (n - 1) : 0;
    const size_t kstride = (size_t)r * NIN;
    const bf16* kbase = P + ((size_t)b * SEQ + (size_t)ub0 * r + c) * NIN + C_KA + hd * AD; const bf16* vbase = kbase + (C_VA - C_KA);
    bf16x8 qf[AD / 32];
#pragma unroll
    for (int ks = 0; ks < AD / 32; ++ks) qf[ks] = *(const GAS bf16x8*)(P + rowq * NIN + C_QA + hd * AD + 32 * ks + 8 * quad);
    f32x4 of[AD / 16];
#pragma unroll
    for (int i = 0; i < AD / 16; ++i) of[i] = (f32x4){0.f, 0.f, 0.f, 0.f};
    float mrun = -1e30f, den = 0.f;
    const int nsc = n > 0 ? 4 : 2;
    v4u rk[AD / 64], rv[AD / 64];
    const unsigned toff = tile_toff<AD>(kstride, tid);
    tile_load<AD>(rk, kbase, kstride, toff); tile_load<AD>(rv, vbase, kstride, toff);
    tile_store<AD, KSTR>(F.lds, rk, tid); tile_store<AD, VSTR>(F.lds + KBUF, rv, tid);
    __syncthreads();
    for (int sc = 0; sc < nsc; ++sc) {
        const LAS unsigned char* Kb = F.lds + (sc & 1) * BUF; LAS unsigned char* Nb = F.lds + ((sc + 1) & 1) * BUF;
        const bool more = sc + 1 < nsc;
        if (more) { tile_load<AD>(rk, kbase + (size_t)(64 * (sc + 1)) * kstride, kstride, toff); tile_load<AD>(rv, vbase + (size_t)(64 * (sc + 1)) * kstride, kstride, toff); }
        f32x4 st[4];
        st_compute<AD, KSTR>(st, Kb, qf, lane);
        const int dq = uq - (ub0 + 64 * sc + 4 * quad);
        float mx = -1e30f;
#pragma unroll
        for (int kg = 0; kg < 4; ++kg)
#pragma unroll
            for (int q = 0; q < 4; ++q) { const int d = dq - (16 * kg + q); const bool ok = d >= 0 && d <= 128; st[kg][q] = ok ? st[kg][q] : -1e30f; mx = fmaxf(mx, st[kg][q]); }
        mx = fmaxf(mx, __shfl_xor(mx, 16)); mx = fmaxf(mx, __shfl_xor(mx, 32));
        const float mnew = fmaxf(mrun, mx), alpha = __builtin_amdgcn_exp2f(mrun - mnew); mrun = mnew;
        float rsum = 0.f;
#pragma unroll
        for (int kg = 0; kg < 4; ++kg)
#pragma unroll
            for (int q = 0; q < 4; ++q) { const float pv = st[kg][q] > -1e29f ? __builtin_amdgcn_exp2f(st[kg][q] - mnew) : 0.f; st[kg][q] = pv; rsum += pv; }
        rsum += __shfl_xor(rsum, 16); rsum += __shfl_xor(rsum, 32);
        den = den * alpha + rsum;
#pragma unroll
        for (int i = 0; i < AD / 16; ++i) of[i] = of[i] * alpha;
        pv_compute<AD, VSTR>(of, Kb + KBUF, st, lane);
        if (more) { tile_store<AD, KSTR>(Nb, rk, tid); tile_store<AD, VSTR>(Nb + KBUF, rv, tid); }
        __syncthreads();
    }
    const float inv = 1.0f / den;
    bf16* op = OB + rowq * AW + hd * AD + 4 * quad;
#pragma unroll
    for (int i = 0; i < AD / 16; ++i) { v2u o; o.x = pg8::cvt_pk_bf16(of[i][0] * inv, of[i][1] * inv); o.y = pg8::cvt_pk_bf16(of[i][2] * inv, of[i][3] * inv); *(GAS v2u*)(op + 16 * i) = o; }
    if (quad == 0) LSE[rowq * AHT + hd] = mrun + __builtin_log2f(den);
}
__device__ __forceinline__ void attn_phase(Frame& F, const bf16* P, bf16* OB, float* LSE) {
    for (int u = blockIdx.x; u < 768; u += F.G) { const int g = u >> 8, v = u & 255, b = v >> 6, hi = (v >> 4) & 3, x = v & 15;
        const int c = g == 0 ? 0 : (g == 1 ? (x >> 2) : x), n = g == 0 ? x : (g == 1 ? (x & 3) : 0);
        attn_unit(F, P, OB, LSE, b, g, hi, c, n); }
}
__device__ __forceinline__ void attn_merge(Frame& F, const bf16* OB, const float* LSE, bf16* YB) {
    for (int e = blockIdx.x * (NWAVES * 64) + F.tid; e < M * 4 * 16; e += F.G * NWAVES * 64) { const int row = e >> 6, hi = (e >> 4) & 3, ch = e & 15;
        const float l0 = LSE[row * AHT + hi], l1 = LSE[row * AHT + 4 + hi], l2 = LSE[row * AHT + 8 + hi], mx = fmaxf(l0, fmaxf(l1, l2));
        float w0 = __builtin_amdgcn_exp2f(l0 - mx), w1 = __builtin_amdgcn_exp2f(l1 - mx), w2 = __builtin_amdgcn_exp2f(l2 - mx); const float inv = 1.0f / (w0 + w1 + w2); w0 *= inv; w1 *= inv; w2 *= inv;
        const bf16* op = OB + (size_t)row * AW + hi * AD + ch * 8;
        const v4u a = *(const GAS v4u*)op, bq = *(const GAS v4u*)(op + 4 * AD), cq = *(const GAS v4u*)(op + 8 * AD);
        v4u o;
        o.x = pg8::cvt_pk_bf16(w0 * bflo(a.x) + w1 * bflo(bq.x) + w2 * bflo(cq.x), w0 * bfhi(a.x) + w1 * bfhi(bq.x) + w2 * bfhi(cq.x));
        o.y = pg8::cvt_pk_bf16(w0 * bflo(a.y) + w1 * bflo(bq.y) + w2 * bflo(cq.y), w0 * bfhi(a.y) + w1 * bfhi(bq.y) + w2 * bfhi(cq.y));
        o.z = pg8::cvt_pk_bf16(w0 * bflo(a.z) + w1 * bflo(bq.z) + w2 * bflo(cq.z), w0 * bfhi(a.z) + w1 * bfhi(bq.z) + w2 * bfhi(cq.z));
        o.w = pg8::cvt_pk_bf16(w0 * bflo(a.w) + w1 * bflo(bq.w) + w2 * bflo(cq.w), w0 * bfhi(a.w) + w1 * bfhi(bq.w) + w2 * bfhi(cq.w));
        *(GAS v4u*)(YB + pg8::tofs(row, hi * AD + ch * 8, AOW)) = o; }
}
struct Args { Ptrs p; int ph_lo, ph_hi; };
__global__ void __launch_bounds__(NWAVES * 64, 2) mk_fwd(Args args) {
    extern __shared__ __attribute__((aligned(16))) unsigned char lds[];
    Frame F;
    F.lds = (LAS unsigned char*)lds;
    F.MISC = (volatile LAS unsigned*)(F.lds + MISC_OFF);
    F.tid = threadIdx.x; F.lane = F.tid & 63; F.wave = __builtin_amdgcn_readfirstlane(F.tid >> 6);
    F.G = gridDim.x; { const int bx = blockIdx.x; F.vcu = (F.G % 8 == 0) ? (bx % 8) * (F.G / 8) + bx / 8 : bx; }
    unsigned char* ws = args.p.ws;
    F.ctl = (gu32*)(ws + WS_CTL);
    for (int u = F.tid; u < (LDS_BYTES - LDSCTL_OFF) / 4; u += NWAVES * 64) ((LAS unsigned*)(F.lds + LDSCTL_OFF))[u] = 0u;
    __syncthreads();
#if MK_PER_PHASE
#define GRID_BAR() do { } while (0)
#else
    XcdBarrier bar = xcd_barrier_post((unsigned*)(F.ctl + CW_BAR), F.MISC + 8);
#define GRID_BAR() xcd_barrier(bar)
#endif
    const int lo = args.ph_lo, hi = args.ph_hi;
#define IN(k) (lo <= (k) && (k) < hi)
#define REPEAT(k) _Pragma("unroll") for (int rep_ = 0; rep_ < ((MK_REPEAT_PHASE == (k)) ? 2 : 1); ++rep_)
#define SEAM(k) do { if (IN(k) && IN((k) + 1)) GRID_BAR(); } while (0)
    const float* x = args.p.in[0]; float* out = args.p.out;
    bf16* XB = (bf16*)(ws + WS_XB); bf16* HB = (bf16*)(ws + WS_H); bf16* PB = (bf16*)(ws + WS_P); bf16* YR = (bf16*)(ws + WS_YR); bf16* OB = (bf16*)(ws + WS_OB); bf16* YB = (bf16*)(ws + WS_YB);
    bf16* MG = (bf16*)(ws + WS_MG); bf16* TB = (bf16*)(ws + WS_T); float* rstd = (float*)(ws + WS_RSTD); float* part = (float*)(ws + WS_PART); float* lse = (float*)(ws + WS_LSE);
    const float* ropec = (const float*)(ws + WS_ROPEC); const float* ropes = (const float*)(ws + WS_ROPES);
    (void)OB; (void)lse;

    if (IN(0)) REPEAT(0) { p0_prologue(F, args.p); } SEAM(0);
    if (IN(1)) REPEAT(1) { pg8::Gemm g{XB, (const bf16*)(ws + WS_WGU1), M, NGU, DM}; pg8::StaticOrder S; S.init(M, NGU, F.G, (int)blockIdx.x);
        pg8::EpiSwiGLU E{HB, DFF, rstd};
        pg8::gemm_phase<pg8::EpiSwiGLU, pg8::StaticOrder, true, true>(F.lds + RING_OFF, g, S, E);
        if (rep_ == 0) tail_convert<1>(F, args.p, ((M / 256) * (NGU / 256)) % F.G); } SEAM(1);
    if (IN(2)) REPEAT(2) { pg8::Gemm g{HB, (const bf16*)(ws + WS_WD1), M, DM, DFF}; pg8::StaticOrder S; S.init(M, DM, F.G, (int)blockIdx.x);
        pg8::EpiResid<false> E{x, nullptr, XB, part, DM, 0.5f};
        pg8::gemm_phase<pg8::EpiResid<false>, pg8::StaticOrder, true, true>(F.lds + RING_OFF, g, S, E); } SEAM(2);
#if MK_NULL_PROBE == 2
    if (IN(2)) { pg8::Gemm g{HB, (const bf16*)(ws + WS_WD1), M, DM, DFF}; pg8::StaticOrder S; S.init(M, DM, F.G, (int)blockIdx.x);
        pg8::EpiNull E{(float*)TB};
        pg8::gemm_phase<pg8::EpiNull, pg8::StaticOrder, true, true>(F.lds + RING_OFF, g, S, E); GRID_BAR(); }
#elif MK_NULL_PROBE == 3
    if (IN(2)) { pg8::Gemm g{XB, (const bf16*)(ws + WS_WGU1), M, NGU, DM}; pg8::SameUnitOrder S;
        pg8::EpiNull E{(float*)TB};
        pg8::gemm_phase<pg8::EpiNull, pg8::SameUnitOrder, true, true>(F.lds + RING_OFF, g, S, E); GRID_BAR(); }
#elif MK_NULL_PROBE == 1
    if (IN(2)) { pg8::Gemm g{XB, (const bf16*)(ws + WS_WGU1), M, NGU, DM}; pg8::StaticOrder S; S.init(M, NGU, F.G, (int)blockIdx.x);
        pg8::EpiNull E{(float*)TB};
        pg8::gemm_phase<pg8::EpiNull, pg8::StaticOrder, true, true>(F.lds + RING_OFF, g, S, E); GRID_BAR(); }
#endif
    if (IN(3)) REPEAT(3) { reduce_rstd(F, part, rstd + M); } SEAM(3);
    if (IN(4)) REPEAT(4) { pg8::Gemm g{XB, (const bf16*)(ws + WS_WIN), M, NIN, DM}; pg8::StaticOrder S; S.init(M, NIN, F.G, (int)blockIdx.x);
        pg8::EpiInProj E{PB, NIN, rstd + M, ropec, ropes};
        pg8::gemm_phase<pg8::EpiInProj, pg8::StaticOrder, true, true>(F.lds + RING_OFF, g, S, E);
        if (rep_ == 0) tail_convert<2>(F, args.p, ((M / 256) * (NIN / 256)) % F.G); } SEAM(4);
    if (IN(5)) REPEAT(5) {
#if MK_NAIVE_MIX
        naive_attn(F, PB, YB);
#else
        attn_phase(F, PB, OB, lse);
#endif
    } SEAM(5);
    if (IN(6)) REPEAT(6) {
#if MK_NAIVE_MIX
        naive_ret(F, PB, YR);
#else
        ret_phase(F, PB, YR); attn_merge(F, OB, lse, YB);
#endif
    } SEAM(6);
    if (IN(7)) REPEAT(7) {
        { pg8::Gemm g{YB, (const bf16*)(ws + WS_WOB), M, DM, AOW}; pg8::StaticOrder S; S.init(M, DM, F.G, (int)blockIdx.x);
          pg8::EpiGateB E{PB + C_UB, NIN, TB, DM};
          pg8::gemm_phase<pg8::EpiGateB, pg8::StaticOrder, true, true>(F.lds + RING_OFF, g, S, E); }
        { pg8::Gemm g{YR, (const bf16*)(ws + WS_WOA), M, DM, RW}; pg8::StaticOrder S; S.init(M, DM, F.G, (int)blockIdx.x);
          pg8::EpiGateA E{PB + C_UA, NIN, TB, DM, MG, DM};
          pg8::gemm_phase<pg8::EpiGateA, pg8::StaticOrder, true, true>(F.lds + RING_OFF, g, S, E); }
    } SEAM(7);
    if (IN(8)) REPEAT(8) { pg8::Gemm g{MG, (const bf16*)(ws + WS_WO), M, DM, DM}; pg8::StaticOrder S; S.init(M, DM, F.G, (int)blockIdx.x);
        pg8::EpiResid<true> E{XB, nullptr, XB, part, DM, 1.0f};
        pg8::gemm_phase<pg8::EpiResid<true>, pg8::StaticOrder, true, true>(F.lds + RING_OFF, g, S, E); } SEAM(8);
    if (IN(9)) REPEAT(9) { reduce_rstd(F, part, rstd + 2 * M); } SEAM(9);
    if (IN(10)) REPEAT(10) { pg8::Gemm g{XB, (const bf16*)(ws + WS_WGU2), M, NGU, DM}; pg8::StaticOrder S; S.init(M, NGU, F.G, (int)blockIdx.x);
        pg8::EpiSwiGLU E{HB, DFF, rstd + 2 * M};
        pg8::gemm_phase<pg8::EpiSwiGLU, pg8::StaticOrder, true, true>(F.lds + RING_OFF, g, S, E);
        if (rep_ == 0) tail_convert<3>(F, args.p, ((M / 256) * (NGU / 256)) % F.G); } SEAM(10);
    if (IN(11)) REPEAT(11) { pg8::Gemm g{HB, (const bf16*)(ws + WS_WD2), M, DM, DFF}; pg8::StaticOrder S; S.init(M, DM, F.G, (int)blockIdx.x);
        pg8::EpiResid<true> E{XB, out, nullptr, part, DM, 0.5f};
        pg8::gemm_phase<pg8::EpiResid<true>, pg8::StaticOrder, true, true>(F.lds + RING_OFF, g, S, E); } SEAM(11);
    if (IN(12)) REPEAT(12) { final_norm(F, out, part, args.p.in[14]); }
#undef IN
#undef SEAM
}

extern "C" void kernel_launch(void* const* d_in, const int* in_sizes, int n_in, void* d_out, int out_size, void* d_ws, size_t ws_size, hipStream_t stream) {
    static int grid = 0;
    if (grid == 0) {
        if (n_in != 15 || in_sizes[0] != M * DM || out_size != M * DM || ws_size < WS_END) { fprintf(stderr, "kernel_launch: unexpected shapes / workspace (n_in %d, in0 %d, out %d, ws %zu, need %zu); nothing launched\n", n_in, n_in > 0 ? in_sizes[0] : -1, out_size, ws_size, (size_t)WS_END); grid = -1; return; }
        int dev = 0, cus = 0, per_cu = 0;
        if (hipGetDevice(&dev) != hipSuccess || hipDeviceGetAttribute(&cus, hipDeviceAttributeMultiprocessorCount, dev) != hipSuccess) { grid = -1; return; }
        if (hipFuncSetAttribute((const void*)mk_fwd, hipFuncAttributeMaxDynamicSharedMemorySize, LDS_BYTES) != hipSuccess) { fprintf(stderr, "kernel_launch: hipFuncSetAttribute failed\n"); grid = -1; return; }
        if (hipOccupancyMaxActiveBlocksPerMultiprocessor(&per_cu, (const void*)mk_fwd, NWAVES * 64, LDS_BYTES) != hipSuccess || per_cu < 1)
            fprintf(stderr, "kernel_launch: note: occupancy query reports %d workgroups per CU\n", per_cu);
        (void)hipGetLastError();
        grid = cus;
    }
    if (grid < 0) return;
    if (hipMemsetAsync((char*)d_ws + WS_CTL, 0, CTL_ZERO_BYTES, stream) != hipSuccess) { fprintf(stderr, "kernel_launch: hipMemsetAsync failed\n"); return; }
    Args a{};
    for (int i = 0; i < 15; ++i) a.p.in[i] = (const float*)d_in[i];
    a.p.out = (float*)d_out; a.p.ws = (unsigned char*)d_ws;
#if MK_PER_PHASE
    for (int li = 0; li < N_PHASES; ++li) { a.ph_lo = li; a.ph_hi = li + 1;
        hipLaunchKernelGGL(mk_fwd, dim3(grid), dim3(NWAVES * 64), LDS_BYTES, stream, a);
        const hipError_t le = hipPeekAtLastError(); if (le != hipSuccess) { fprintf(stderr, "kernel_launch: launch %d failed: %s\n", li, hipGetErrorName(le)); break; } }
#else
    a.ph_lo = 0; a.ph_hi = N_PHASES;
    hipLaunchKernelGGL(mk_fwd, dim3(grid), dim3(NWAVES * 64), LDS_BYTES, stream, a);
    const hipError_t le = hipPeekAtLastError(); if (le != hipSuccess) fprintf(stderr, "kernel_launch: launch failed: %s\n", hipGetErrorName(le));
#endif
}
```

```cpp
#include <hip/hip_runtime.h>
#include <cstdio>
#include <cstdint>
namespace pg8 {
#define PG8_LAS __attribute__((address_space(3)))
typedef unsigned short bf16_t;
typedef short bf16x8 __attribute__((ext_vector_type(8)));
typedef float f32x4 __attribute__((ext_vector_type(4)));
typedef unsigned u32x4 __attribute__((ext_vector_type(4)));
constexpr int BM = 256, BK = 64, HALF = 128, HTB = HALF * BK * 2  , STAGE_BYTES = 8 * HTB, NXCD = 8, WGM = 8;

__host__ __device__ __forceinline__ int lds_byte(int r, int c) { const int st = (r >> 4) * 2 + (c >> 5), rr = r & 15, cc = c & 31, ob = rr * 64 + cc * 2; return st * 1024 + (ob ^ (((ob >> 9) & 1) << 5)); }
__host__ __device__ __forceinline__ void stage_rc(int b, int& R, int& C) { const int st = b / 1024, sb = b % 1024, swz = sb ^ (((sb >> 9) & 1) << 5); R = (st >> 1) * 16 + swz / 64; C = (st & 1) * 32 + (swz % 64) / 2; }
__host__ __device__ __forceinline__ int perm32(int rho) { const int n = rho >> 4, i = rho & 15; return 8 * (i >> 2) + 4 * n + (i & 3); }

struct Unit { int pm, pn; };
struct Gemm { const bf16_t* A; const bf16_t* Bt; int M, N, K; };

struct StaticOrder {
    int nM, nN, nwg, G, c;
    __host__ __device__ void init(int M, int N, int G_, int c_) { nM = M / BM; nN = N / BM; nwg = nM * nN; G = G_; c = c_; }
    __host__ __device__ bool next(int i, Unit& u) const {
        const long L = (long)i * G + c; if (L >= nwg) return false;
        int wgid = (int)L; { const int q = nwg / NXCD, r = nwg % NXCD, xcd = wgid % NXCD, off = wgid / NXCD; wgid = (xcd < r ? xcd * (q + 1) : r * (q + 1) + (xcd - r) * q) + off; }
        const int nig = WGM * nN, gid = wgid / nig, fm = gid * WGM, gsz = (nM - fm) < WGM ? (nM - fm) : WGM;
        u.pm = fm + ((wgid % nig) % gsz); u.pn = (wgid % nig) / gsz; return true;
    }
    __device__ __forceinline__ void a_ready(const Unit&) const {}
    __device__ __forceinline__ void done(const Unit&) const {}
};

__device__ __forceinline__ unsigned cvt_pk_bf16(float lo, float hi) { unsigned r; asm volatile("v_cvt_pk_bf16_f32 %0, %1, %2" : "=v"(r) : "v"(lo), "v"(hi)); return r; }
typedef float f32x2 __attribute__((ext_vector_type(2)));
typedef unsigned u32x2 __attribute__((ext_vector_type(2)));
__host__ __device__ __forceinline__ size_t tofs(int r, int k, int K) { return ((size_t)(r >> 8) * (size_t)(K >> 6) + (size_t)(k >> 6)) * 16384 + (size_t)((r & 255) * 64 + (k & 63)); }
__device__ __forceinline__ float sigm(float v) { return __builtin_amdgcn_rcpf(1.0f + __builtin_amdgcn_exp2f(-1.4426950408889634f * v)); }
__device__ __forceinline__ f32x4 sigm4(f32x4 v) { return (f32x4){sigm(v[0]), sigm(v[1]), sigm(v[2]), sigm(v[3])}; }
__device__ __forceinline__ f32x4 bfx4_lo(u32x4 w) { return (f32x4){__uint_as_float(w.x << 16), __uint_as_float(w.x & 0xffff0000u), __uint_as_float(w.y << 16), __uint_as_float(w.y & 0xffff0000u)}; }
__device__ __forceinline__ f32x4 bfx4_hi(u32x4 w) { return (f32x4){__uint_as_float(w.z << 16), __uint_as_float(w.z & 0xffff0000u), __uint_as_float(w.w << 16), __uint_as_float(w.w & 0xffff0000u)}; }
__device__ __forceinline__ u32x4 pack8(f32x4 a, f32x4 b) { u32x4 w; w.x = cvt_pk_bf16(a[0], a[1]); w.y = cvt_pk_bf16(a[2], a[3]); w.z = cvt_pk_bf16(b[0], b[1]); w.w = cvt_pk_bf16(b[2], b[3]); return w; }

struct EpiSwiGLU {
    static constexpr bool PERM = true, AFTER_DRAIN = false;
    bf16_t* H; int ldh; const float* rstd;
    __device__ __forceinline__ void operator()(const f32x4 (&acc)[2][2][4][2], const Unit& u, int wr, int wc, int fr, int fq) const {
        const int row0 = u.pm * BM + wr * 64 + fr, col0 = u.pn * HALF + wc * 32 + 8 * fq;
        float rs[2][4];
#pragma unroll
        for (int ai = 0; ai < 2; ++ai)
#pragma unroll
            for (int m = 0; m < 4; ++m) rs[ai][m] = rstd[row0 + ai * HALF + m * 16];
#pragma unroll
        for (int ai = 0; ai < 2; ++ai)
#pragma unroll
            for (int m = 0; m < 4; ++m) { const int row = row0 + ai * HALF + m * 16; const float r = rs[ai][m];
                const f32x4 g0 = acc[ai][0][m][0] * r, g1 = acc[ai][0][m][1] * r, u0 = acc[ai][1][m][0] * r, u1 = acc[ai][1][m][1] * r;
                const f32x4 h0 = g0 * sigm4(g0) * u0, h1 = g1 * sigm4(g1) * u1;
                *(u32x4*)(H + tofs(row, col0, ldh)) = pack8(h0, h1); }
    }
};
template <bool BASE_BF16> struct EpiResid {
    static constexpr bool PERM = false, AFTER_DRAIN = false;
    const void* base; float* out; bf16_t* xb; float* part; int ldc; float scale;
    __device__ __forceinline__ void operator()(const f32x4 (&acc)[2][2][4][2], const Unit& u, int wr, int wc, int fr, int fq) const {
        const int row0 = u.pm * BM + wr * 64 + fr, col0 = u.pn * BM + wc * 32 + 4 * fq;
#pragma unroll
        for (int ai = 0; ai < 2; ++ai) {
            f32x4 b[4][2][2]; u32x2 bw[4][2][2];
#pragma unroll
            for (int m = 0; m < 4; ++m) { const int row = row0 + ai * HALF + m * 16;
#pragma unroll
                for (int bj = 0; bj < 2; ++bj)
#pragma unroll
                    for (int n = 0; n < 2; ++n) {
                        if (BASE_BF16) bw[m][bj][n] = *(const u32x2*)((const bf16_t*)base + tofs(row, col0 + bj * HALF + n * 16, ldc));
                        else b[m][bj][n] = *(const f32x4*)((const float*)base + (size_t)row * ldc + col0 + bj * HALF + n * 16); } }
#pragma unroll
            for (int m = 0; m < 4; ++m) { const int row = row0 + ai * HALF + m * 16; const size_t off = (size_t)row * ldc + col0; float ss = 0.f;
#pragma unroll
                for (int bj = 0; bj < 2; ++bj)
#pragma unroll
                    for (int n = 0; n < 2; ++n) { const size_t tof = tofs(row, col0 + bj * HALF + n * 16, ldc);
                        if (BASE_BF16) { const u32x2 w = bw[m][bj][n]; b[m][bj][n] = (f32x4){__uint_as_float(w.x << 16), __uint_as_float(w.x & 0xffff0000u), __uint_as_float(w.y << 16), __uint_as_float(w.y & 0xffff0000u)}; }
                        const f32x4 v = b[m][bj][n] + acc[ai][bj][m][n] * scale;
                        if (out) *(f32x4*)(out + off + bj * HALF + n * 16) = v;
                        ss += (v[0] * v[0] + v[1] * v[1]) + (v[2] * v[2] + v[3] * v[3]);
                        if (xb) { u32x2 w; w.x = cvt_pk_bf16(v[0], v[1]); w.y = cvt_pk_bf16(v[2], v[3]); *(u32x2*)(xb + tof) = w; } }
                ss += __shfl_xor(ss, 16); ss += __shfl_xor(ss, 32);
                if (fq == 0) part[(size_t)row * 64 + u.pn * 4 + wc] = ss; }
        }
    }
};
struct EpiInProj {
    static constexpr bool PERM = true, AFTER_DRAIN = false;
    bf16_t* P; int ldp; const float* rstd; const float* ropec; const float* ropes;
    __device__ __forceinline__ void operator()(const f32x4 (&acc)[2][2][4][2], const Unit& u, int wr, int wc, int fr, int fq) const {
        const int row0 = u.pm * BM + wr * 64 + fr, d0 = wc * 32 + 8 * fq, col0 = u.pn * BM + d0; const int pn = u.pn;
        float rs[2][4];
#pragma unroll
        for (int ai = 0; ai < 2; ++ai)
#pragma unroll
            for (int m = 0; m < 4; ++m) rs[ai][m] = rstd[row0 + ai * HALF + m * 16];
#pragma unroll
        for (int ai = 0; ai < 2; ++ai) {
            f32x4 cs[4][4];
            if (pn < 16) {
#pragma unroll
                for (int m = 0; m < 4; ++m) { const int pos = (row0 + ai * HALF + m * 16) & 2047; const float* cp = ropec + pos * 128 + d0; const float* sp = ropes + pos * 128 + d0;
                    cs[m][0] = *(const f32x4*)cp; cs[m][1] = *(const f32x4*)(cp + 4); cs[m][2] = *(const f32x4*)sp; cs[m][3] = *(const f32x4*)(sp + 4); } }
#pragma unroll
            for (int m = 0; m < 4; ++m) { const int row = row0 + ai * HALF + m * 16; const float r = rs[ai][m];
                f32x4 a0 = acc[ai][0][m][0] * r, a1 = acc[ai][0][m][1] * r, b0 = acc[ai][1][m][0] * r, b1 = acc[ai][1][m][1] * r;
                if (pn < 16) { const f32x4 c0 = cs[m][0], c1 = cs[m][1], s0 = cs[m][2], s1 = cs[m][3];
                    const float sc = pn < 8 ? 1.0f : 0.0625f;
                    const f32x4 x0 = (a0 * c0 - b0 * s0) * sc, x1 = (a1 * c1 - b1 * s1) * sc, y0 = (b0 * c0 + a0 * s0) * sc, y1 = (b1 * c1 + a1 * s1) * sc;
                    a0 = x0; a1 = x1; b0 = y0; b1 = y1; }
                else if (pn < 24) { }
                else if (pn < 32) { a0 = a0 * sigm4(a0); a1 = a1 * sigm4(a1); b0 = b0 * sigm4(b0); b1 = b1 * sigm4(b1); }
                else if (pn < 38) { const float sc = 0.12751743082459868f; a0 = a0 * sc; a1 = a1 * sc; b0 = b0 * sc; b1 = b1 * sc; }
                else if (pn < 50) { }
                else { a0 = sigm4(a0); a1 = sigm4(a1); b0 = sigm4(b0); b1 = sigm4(b1); }
                bf16_t* rowp = P + (size_t)row * ldp + col0;
                *(u32x4*)rowp = pack8(a0, a1); *(u32x4*)(rowp + HALF) = pack8(b0, b1); }
        }
    }
};
struct EpiGateB {
    static constexpr bool PERM = true, AFTER_DRAIN = false;
    const bf16_t* G; int ldg; bf16_t* T; int ldt;
    __device__ __forceinline__ void operator()(const f32x4 (&acc)[2][2][4][2], const Unit& u, int wr, int wc, int fr, int fq) const {
        const int row0 = u.pm * BM + wr * 64 + fr, col0 = u.pn * BM + wc * 32 + 8 * fq;
        u32x4 gw[2][4][2];
#pragma unroll
        for (int ai = 0; ai < 2; ++ai)
#pragma unroll
            for (int m = 0; m < 4; ++m)
#pragma unroll
                for (int bj = 0; bj < 2; ++bj) gw[ai][m][bj] = *(const u32x4*)(G + (size_t)(row0 + ai * HALF + m * 16) * ldg + col0 + bj * HALF);
#pragma unroll
        for (int ai = 0; ai < 2; ++ai)
#pragma unroll
            for (int m = 0; m < 4; ++m) { const int row = row0 + ai * HALF + m * 16;
#pragma unroll
                for (int bj = 0; bj < 2; ++bj)
                    *(u32x4*)(T + (size_t)row * ldt + col0 + bj * HALF) = pack8(bfx4_lo(gw[ai][m][bj]) * acc[ai][bj][m][0], bfx4_hi(gw[ai][m][bj]) * acc[ai][bj][m][1]); }
    }
};
struct EpiGateA {
    static constexpr bool PERM = true, AFTER_DRAIN = false;
    const bf16_t* G; int ldg; const bf16_t* T; int ldt; bf16_t* O; int ldo;
    __device__ __forceinline__ void operator()(const f32x4 (&acc)[2][2][4][2], const Unit& u, int wr, int wc, int fr, int fq) const {
        const int row0 = u.pm * BM + wr * 64 + fr, col0 = u.pn * BM + wc * 32 + 8 * fq;
#pragma unroll
        for (int ai = 0; ai < 2; ++ai) {
            u32x4 gw[4][2], tw[4][2];
#pragma unroll
            for (int m = 0; m < 4; ++m)
#pragma unroll
                for (int bj = 0; bj < 2; ++bj) { const int row = row0 + ai * HALF + m * 16; gw[m][bj] = *(const u32x4*)(G + (size_t)row * ldg + col0 + bj * HALF); tw[m][bj] = *(const u32x4*)(T + (size_t)row * ldt + col0 + bj * HALF); }
#pragma unroll
            for (int m = 0; m < 4; ++m) { const int row = row0 + ai * HALF + m * 16;
#pragma unroll
                for (int bj = 0; bj < 2; ++bj)
                    *(u32x4*)(O + tofs(row, col0 + bj * HALF, ldo)) = pack8(bfx4_lo(gw[m][bj]) * acc[ai][bj][m][0] + bfx4_lo(tw[m][bj]), bfx4_hi(gw[m][bj]) * acc[ai][bj][m][1] + bfx4_hi(tw[m][bj])); }
        }
    }
};
struct EpiNull {
    static constexpr bool PERM = true, AFTER_DRAIN = false;
    float* sink;
    __device__ __forceinline__ void operator()(const f32x4 (&acc)[2][2][4][2], const Unit& u, int wr, int wc, int fr, int fq) const {
        f32x4 s = (f32x4){0.f, 0.f, 0.f, 0.f};
#pragma unroll
        for (int ai = 0; ai < 2; ++ai)
#pragma unroll
            for (int bj = 0; bj < 2; ++bj)
#pragma unroll
                for (int m = 0; m < 4; ++m)
#pragma unroll
                    for (int n = 0; n < 2; ++n) s += acc[ai][bj][m][n];
        if ((s[0] + s[1]) + (s[2] + s[3]) == 12345.678f) sink[u.pm * 16 + u.pn] = s[0];
    }
};

struct SameUnitOrder {
    __device__ bool next(int i, Unit& u) const { if (i >= 11) return false; u.pm = 0; u.pn = 0; return true; }
    __device__ __forceinline__ void a_ready(const Unit&) const {}
    __device__ __forceinline__ void done(const Unit&) const {}
};
struct PanelOrder {
    StaticOrder so; bool fast; int c;
    __host__ __device__ void init(int M, int N, int G_, int c_) { so.init(M, N, G_, c_); c = c_; fast = (G_ == 256 && so.nM == 32 && so.nN == 16); }
    __host__ __device__ bool next(int i, Unit& u) const {
        if (!fast) return so.next(i, u);
        if (i >= 2) return false;
        const int x = c & 7, j = c >> 3; u.pm = 16 * i + 4 * (x >> 1) + (j & 3); u.pn = 8 * (x & 1) + (j >> 2); return true;
    }
    __device__ __forceinline__ void a_ready(const Unit&) const {}
    __device__ __forceinline__ void done(const Unit&) const {}
};
template <class Epi, class Sched, bool ALIGN_EPI = false, bool SP2 = false>
__device__ __forceinline__ void gemm_phase(PG8_LAS unsigned char* lds, const Gemm g, const Sched& S, const Epi& E) {
    const int tid = threadIdx.x, wid = __builtin_amdgcn_readfirstlane(tid >> 6), lane = tid & 63, wr = wid >> 2, wc = wid & 3, fr = lane & 15, fq = lane >> 4;
    const int K = g.K, nt = K / BK;
    unsigned voffA[2], voffB[2];
#pragma unroll
    for (int i = 0; i < 2; ++i) { int R, C; stage_rc(tid * 16 + i * 8192, R, C); const int Rb = Epi::PERM ? ((R & ~31) + perm32(R & 31)) : R;
        voffA[i] = (unsigned)(R * BK + C) * 2u; voffB[i] = (unsigned)(Rb * BK + C) * 2u; }
    const size_t kstep = (size_t)(BM * BK * 2);
    const size_t hstep = (size_t)HALF * BK * 2;
    const size_t tstep = (size_t)BM * K * 2;
    const unsigned ldsw = (unsigned)wid * 1024u;
    const int aoff = lds_byte(wr * 64 + fr, fq * 8), boff = lds_byte(wc * 32 + fr, fq * 8);
#define PG8_SA(b, h) (((b) * 2 + (h)) * HTB)
#define PG8_SB(b, h) ((4 + (b) * 2 + (h)) * HTB)
#define PG8_STAGE(bufoff, gbase, voff) do { _Pragma("unroll") for (int _i = 0; _i < 2; ++_i) \
        __builtin_amdgcn_global_load_lds((const unsigned*)((const char*)(gbase) + (voff)[_i]), (PG8_LAS unsigned*)(lds + (bufoff) + ldsw + _i * 8192), 16, 0, 0); } while (0)
#define PG8_LDA(dst, b, h) do { _Pragma("unroll") for (int m = 0; m < 4; ++m) _Pragma("unroll") for (int k = 0; k < 2; ++k) dst[m][k] = *(const PG8_LAS bf16x8*)(lds + PG8_SA(b, h) + aoff + m * 2048 + k * 1024); } while (0)
#define PG8_LDB(dst, b, h) do { _Pragma("unroll") for (int n = 0; n < 2; ++n) _Pragma("unroll") for (int k = 0; k < 2; ++k) dst[n][k] = *(const PG8_LAS bf16x8*)(lds + PG8_SB(b, h) + boff + n * 2048 + k * 1024); } while (0)
#define PG8_MMA(ai, bj, At, Bt) do { __builtin_amdgcn_s_setprio(1); _Pragma("unroll") for (int m = 0; m < 4; ++m) _Pragma("unroll") for (int n = 0; n < 2; ++n) _Pragma("unroll") for (int k = 0; k < 2; ++k) \
        acc[ai][bj][m][n] = __builtin_amdgcn_mfma_f32_16x16x32_bf16(Bt[n][k], At[m][k], acc[ai][bj][m][n], 0, 0, 0); __builtin_amdgcn_s_setprio(0); } while (0)
#define PG8_WAIT_V(n) asm volatile("s_waitcnt vmcnt(" #n ")" ::: "memory")
#define PG8_WAIT_L(n) asm volatile("s_waitcnt lgkmcnt(" #n ")" ::: "memory")
#define PG8_BAR __builtin_amdgcn_s_barrier()
#define PG8_SCHED __builtin_amdgcn_sched_barrier(0)
    Unit cur, nxt; int ui = 0;
    if (!S.next(0, cur)) return;
    f32x4 acc[2][2][4][2];
#pragma unroll
    for (int a = 0; a < 2; ++a)
#pragma unroll
        for (int b = 0; b < 2; ++b)
#pragma unroll
            for (int m = 0; m < 4; ++m)
#pragma unroll
                for (int n = 0; n < 2; ++n) acc[a][b][m][n] = (f32x4){0.f, 0.f, 0.f, 0.f};
    bf16x8 At[4][2], B0[2][2], B1[2][2];
    const char* cA = (const char*)g.A + (size_t)cur.pm * tstep; const char* cB = (const char*)g.Bt + (size_t)cur.pn * tstep;
    S.a_ready(cur);
    if constexpr (SP2) {
        PG8_STAGE(PG8_SB(0, 0), cB, voffB); PG8_STAGE(PG8_SB(0, 1), cB + hstep, voffB); PG8_STAGE(PG8_SA(0, 0), cA, voffA); PG8_STAGE(PG8_SA(0, 1), cA + hstep, voffA);
        if (wr == 1) PG8_BAR;
        PG8_WAIT_V(2); PG8_BAR;
        PG8_STAGE(PG8_SB(1, 0), cB + kstep, voffB); PG8_STAGE(PG8_SA(1, 0), cA + kstep, voffA); PG8_STAGE(PG8_SB(1, 1), cB + hstep + kstep, voffB);
        PG8_WAIT_V(6); PG8_BAR;
    } else {
        PG8_STAGE(PG8_SB(0, 0), cB, voffB); PG8_STAGE(PG8_SA(0, 0), cA, voffA); PG8_STAGE(PG8_SB(0, 1), cB + hstep, voffB); PG8_STAGE(PG8_SA(0, 1), cA + hstep, voffA);
        if (wr == 1) PG8_BAR;
        PG8_WAIT_V(4); PG8_BAR;
        PG8_STAGE(PG8_SB(1, 0), cB + kstep, voffB); PG8_STAGE(PG8_SA(1, 0), cA + kstep, voffA); PG8_STAGE(PG8_SB(1, 1), cB + hstep + kstep, voffB);
        PG8_WAIT_V(6); PG8_BAR;
    }
    for (;;) {
        const bool has_next = S.next(ui + 1, nxt);
        const char* nA = has_next ? (const char*)g.A + (size_t)nxt.pm * tstep : cA; const char* nB = has_next ? (const char*)g.Bt + (size_t)nxt.pn * tstep : cB;
        for (int t = 0; t < nt; t += 2) {
            const bool last = (t == nt - 2);
            const char* a1 = cA + (size_t)(t + 1) * kstep;
            const char* a2 = last ? nA : cA + (size_t)(t + 2) * kstep; const char* b2 = last ? nB : cB + (size_t)(t + 2) * kstep;
            const char* a3 = a2 + kstep; const char* b3 = b2 + kstep;
            if (last && has_next) S.a_ready(nxt);
            if constexpr (SP2) {
            PG8_LDB(B0, 0, 0); PG8_LDB(B1, 0, 1); PG8_SCHED; PG8_LDA(At, 0, 0); PG8_STAGE(PG8_SA(1, 1), a1 + hstep, voffA);
            PG8_WAIT_V(8); PG8_WAIT_L(0); PG8_BAR; PG8_MMA(0, 0, At, B0); PG8_MMA(0, 1, At, B1); PG8_BAR; PG8_SCHED;
            PG8_LDA(At, 0, 1); PG8_STAGE(PG8_SB(0, 0), b2, voffB); PG8_STAGE(PG8_SB(0, 1), b2 + hstep, voffB); PG8_STAGE(PG8_SA(0, 0), a2, voffA);
            PG8_WAIT_V(8); PG8_WAIT_L(0); PG8_BAR; PG8_MMA(1, 0, At, B0); PG8_MMA(1, 1, At, B1); PG8_BAR; PG8_SCHED;
            PG8_LDB(B0, 1, 0); PG8_LDB(B1, 1, 1); PG8_SCHED; PG8_LDA(At, 1, 0); PG8_STAGE(PG8_SA(0, 1), a2 + hstep, voffA);
            PG8_WAIT_V(8); PG8_WAIT_L(0); PG8_BAR; PG8_MMA(0, 0, At, B0); PG8_MMA(0, 1, At, B1); PG8_BAR; PG8_SCHED;
            PG8_LDA(At, 1, 1); PG8_STAGE(PG8_SB(1, 0), b3, voffB); PG8_STAGE(PG8_SB(1, 1), b3 + hstep, voffB); PG8_STAGE(PG8_SA(1, 0), a3, voffA);
            PG8_WAIT_V(8); PG8_WAIT_L(0); PG8_BAR; PG8_MMA(1, 0, At, B0); PG8_MMA(1, 1, At, B1); PG8_BAR; PG8_SCHED;
            } else {
            PG8_LDB(B0, 0, 0); PG8_SCHED; PG8_LDA(At, 0, 0); PG8_STAGE(PG8_SA(1, 1), a1 + hstep, voffA);
            PG8_WAIT_L(8); PG8_BAR; PG8_WAIT_L(0); PG8_MMA(0, 0, At, B0); PG8_BAR; PG8_SCHED;
            PG8_LDB(B1, 0, 1); PG8_STAGE(PG8_SB(0, 0), b2, voffB);
            PG8_BAR; PG8_WAIT_L(0); PG8_MMA(0, 1, At, B1); PG8_BAR;
            PG8_LDA(At, 0, 1); PG8_STAGE(PG8_SA(0, 0), a2, voffA);
            PG8_BAR; PG8_WAIT_L(0); PG8_MMA(1, 0, At, B0); PG8_BAR; PG8_SCHED;
            PG8_STAGE(PG8_SB(0, 1), b2 + hstep, voffB);
            PG8_WAIT_V(6); PG8_BAR; PG8_MMA(1, 1, At, B1); PG8_BAR;
            PG8_LDB(B0, 1, 0); PG8_SCHED; PG8_LDA(At, 1, 0); PG8_STAGE(PG8_SA(0, 1), a2 + hstep, voffA);
            PG8_WAIT_L(8); PG8_BAR; PG8_WAIT_L(0); PG8_MMA(0, 0, At, B0); PG8_BAR; PG8_SCHED;
            PG8_LDB(B1, 1, 1); PG8_STAGE(PG8_SB(1, 0), b3, voffB);
            PG8_BAR; PG8_WAIT_L(0); PG8_MMA(0, 1, At, B1); PG8_BAR;
            PG8_LDA(At, 1, 1); PG8_STAGE(PG8_SA(1, 0), a3, voffA);
            PG8_BAR; PG8_WAIT_L(0); PG8_MMA(1, 0, At, B0); PG8_BAR; PG8_SCHED;
            PG8_STAGE(PG8_SB(1, 1), b3 + hstep, voffB);
            PG8_WAIT_V(6); PG8_BAR; PG8_MMA(1, 1, At, B1); PG8_BAR;
            }
        }
        if constexpr (ALIGN_EPI) { if (wr == 0) PG8_BAR; }
        if constexpr (!Epi::AFTER_DRAIN) { E(acc, cur, wr, wc, fr, fq); S.done(cur); }
        if (!has_next) break;
#pragma unroll
        for (int a = 0; a < 2; ++a)
#pragma unroll
            for (int b = 0; b < 2; ++b)
#pragma unroll
                for (int m = 0; m < 4; ++m)
#pragma unroll
                    for (int n = 0; n < 2; ++n) acc[a][b][m][n] = (f32x4){0.f, 0.f, 0.f, 0.f};
        cur = nxt; cA = nA; cB = nB; ++ui;
        if constexpr (ALIGN_EPI) { if (wr == 1) PG8_BAR; }
    }
    PG8_WAIT_V(0);
    if constexpr (!ALIGN_EPI) { if (wr == 0) PG8_BAR; }
    PG8_BAR;
    if constexpr (Epi::AFTER_DRAIN) { E.fused(acc, cur, wr, wc, fr, fq, lds, wid, lane); S.done(cur); }
#undef PG8_SA
#undef PG8_SB
#undef PG8_STAGE
#undef PG8_LDA
#undef PG8_LDB
#undef PG8_MMA
#undef PG8_WAIT_V
#undef PG8_WAIT_L
#undef PG8_BAR
#undef PG8_SCHED
}
}
constexpr int NWAVES = 8;
#ifndef MK_PER_PHASE
#define MK_PER_PHASE 0
#endif
#ifndef MK_NAIVE_MIX
#define MK_NAIVE_MIX 0
#endif
#ifndef MK_REPEAT_PHASE
#define MK_REPEAT_PHASE -1
#endif
#ifndef MK_NULL_PROBE
#define MK_NULL_PROBE 0
#endif
#ifndef MK_VAR
#define MK_VAR 0
#endif
#ifndef MK_WIN_LATE
#define MK_WIN_LATE 1
#endif
constexpr int N_PHASES = 13;

constexpr int BATCH = 4, SEQ = 2048, DM = 4096, M = BATCH * SEQ, DFF = 11008, NGU = 2 * DFF;
constexpr int RW = 2048, RH = 8, RD = 256, AW = 1536, AHT = 12, AD = 128, AOW = 512, NIN = 20992;
constexpr int C_QR = 0, C_KR = 2048, C_VR = 4096, C_GR = 6144, C_QA = 8192, C_KA = 9728, C_VA = 11264, C_UA = 12800, C_UB = 16896;
constexpr float EPS = 1e-6f;

constexpr size_t MiB = 1u << 20;
constexpr size_t WS_CTL = 0, CTL_ZERO_BYTES = 1 * MiB;
constexpr size_t WS_ROPEC = 2 * MiB, WS_ROPES = 3 * MiB;
constexpr size_t WS_RSTD = 4 * MiB;
constexpr size_t WS_PART = 5 * MiB;
constexpr size_t WS_LSE = 7 * MiB;
constexpr size_t WS_WGU1 = 8 * MiB, WS_WD1 = WS_WGU1 + 172 * MiB, WS_WIN = WS_WD1 + 86 * MiB, WS_WOA = WS_WIN + 164 * MiB, WS_WOB = WS_WOA + 16 * MiB,
                 WS_WO = WS_WOB + 4 * MiB, WS_WGU2 = WS_WO + 32 * MiB, WS_WD2 = WS_WGU2 + 172 * MiB;
constexpr size_t WS_XB = WS_WD2 + 86 * MiB;
constexpr size_t WS_P = WS_XB + 64 * MiB;
constexpr size_t WS_H = WS_P;
constexpr size_t WS_YR = WS_P + 328 * MiB;
constexpr size_t WS_OB = WS_YR + 32 * MiB;
constexpr size_t WS_YB = WS_OB + 24 * MiB;
constexpr size_t WS_T = WS_YB + 8 * MiB;
constexpr size_t WS_MG = WS_T + 128 * MiB;
constexpr size_t WS_END = WS_MG + 64 * MiB;
static_assert((size_t)NGU * DM * 2 == 172 * MiB && (size_t)DM * DFF * 2 == 86 * MiB && (size_t)NIN * DM * 2 == 164 * MiB && (size_t)M * NIN * 2 == 328 * MiB && (size_t)M * DFF * 2 == 172 * MiB, "d_ws map");
constexpr int CW_TMO = 0, CW_CODE = 1;
constexpr int CW_BAR = 4096;

constexpr int RING_OFF = 0, RING_BYTES = 131072;
constexpr int LDSCTL_OFF = 139264, MISC_OFF = LDSCTL_OFF + 320;
constexpr int LDS_BYTES = 147456;
static_assert(MISC_OFF + 128 <= LDS_BYTES, "LDS map");

#define GAS __attribute__((address_space(1)))
#define LAS __attribute__((address_space(3)))
typedef unsigned short bf16;
typedef unsigned v4u __attribute__((ext_vector_type(4)));
typedef unsigned v2u __attribute__((ext_vector_type(2)));
typedef float f32x4 __attribute__((ext_vector_type(4)));
typedef short bf16x8 __attribute__((ext_vector_type(8)));
typedef GAS unsigned gu32;
typedef GAS unsigned long long gu64;
#define RLX_AGENT __ATOMIC_RELAXED, __HIP_MEMORY_SCOPE_AGENT
#define LDS_WAIT() asm volatile("s_waitcnt lgkmcnt(0)" ::: "memory")
#define VM_WAIT() asm volatile("s_waitcnt vmcnt(0)" ::: "memory")
__device__ __forceinline__ unsigned f2bf(float f) { unsigned u = __builtin_bit_cast(unsigned, f); return (u + 0x7fffu + ((u >> 16) & 1u)) >> 16; }
__device__ __forceinline__ unsigned pk2(float lo, float hi) { return f2bf(lo) | (f2bf(hi) << 16); }
__device__ __forceinline__ float bf2f(bf16 h) { return __uint_as_float((unsigned)h << 16); }
__device__ __forceinline__ float bflo(unsigned w) { return __uint_as_float(w << 16); }
__device__ __forceinline__ float bfhi(unsigned w) { return __uint_as_float(w & 0xffff0000u); }

#define XB_TMO      128
#define XB_XCNT(j)  (256  + 64 * (j))
#define XB_XSUB(j)  (1280 + 64 * (j))
#define XB_XGEN(j)  (2304 + 64 * (j))
#define XB_TOP      3328
#define XB_TOPGEN   3392
#define XCD_BAR_WORDS 3456
#define XB_SPIN_CAP (1u << 18)

__device__ __forceinline__ unsigned xb_ld(unsigned* p)              { return __hip_atomic_load(p, __ATOMIC_RELAXED, __HIP_MEMORY_SCOPE_AGENT); }
__device__ __forceinline__ unsigned xb_add(unsigned* p, unsigned v) { return __hip_atomic_fetch_add(p, v, __ATOMIC_RELAXED, __HIP_MEMORY_SCOPE_AGENT); }
__device__ __forceinline__ unsigned xb_xcc_id() { return (unsigned)__builtin_amdgcn_s_getreg((3 << 11) | 20) & 0xFu; }
#define XB_SPIN(cond, bar) do { unsigned _sp = 0; while (cond) { __builtin_amdgcn_s_sleep(1); \
    if ((++_sp & 255u) == 0u) { if (xb_ld(&(bar)[XB_TMO])) break; if (_sp > XB_SPIN_CAP) { atomicAdd(&(bar)[XB_TMO], 1u); break; } } } } while (0)

struct XcdBarrier {
    unsigned* bar; unsigned x;
    volatile LAS unsigned* st;
};

__device__ __forceinline__ XcdBarrier xcd_barrier_post(unsigned* bar, volatile LAS unsigned* st) {
    XcdBarrier b; b.bar = bar; b.x = xb_xcc_id(); b.st = st;
    if (threadIdx.x == 0) (void)xb_add(&bar[XB_XCNT(b.x)], 1u);
    return b;
}
__device__ __forceinline__ void xcd_barrier_complete(unsigned* bar, unsigned x, unsigned& nloc, unsigned& nx) {
    const unsigned G = gridDim.x * gridDim.y * gridDim.z;
    unsigned sum, cnt, mine, sp = 0u;
    for (;;) {
        sum = 0u; cnt = 0u; mine = 0u;
#pragma unroll
        for (unsigned j = 0; j < 16; ++j) { const unsigned c = xb_ld(&bar[XB_XCNT(j)]); sum += c; cnt += (c > 0u) ? 1u : 0u; mine = (j == x) ? c : mine; }
        if (sum == G) break;
        __builtin_amdgcn_s_sleep(1);
        if ((++sp & 255u) == 0u) { if (xb_ld(&bar[XB_TMO])) break; if (sp > XB_SPIN_CAP) { atomicAdd(&bar[XB_TMO], 1u); break; } }
    }
    nloc = mine > 0u ? mine : 1u; nx = cnt > 0u ? cnt : 1u;
}

__device__ __forceinline__ void xcd_barrier(const XcdBarrier& b) {
    asm volatile("s_waitcnt vmcnt(0)" ::: "memory");
    __syncthreads();
    if (threadIdx.x == 0) {
        unsigned* bar = b.bar;
        __builtin_amdgcn_s_waitcnt(0);
        unsigned nloc = b.st[0], nx = b.st[1];
        if (nloc == 0u) { xcd_barrier_complete(bar, b.x, nloc, nx); b.st[0] = nloc; b.st[1] = nx; }
        const unsigned old = xb_add(&bar[XB_XSUB(b.x)], 1u);
        const unsigned gen = old / nloc;
        if (old + 1u == (gen + 1u) * nloc) {
            __builtin_amdgcn_fence(__ATOMIC_RELEASE, "agent");
            asm volatile("s_waitcnt vmcnt(0)" ::: "memory");
            const unsigned og = xb_add(&bar[XB_TOP], 1u);
            const unsigned tg = og / nx;
            if (og + 1u == (tg + 1u) * nx) xb_add(&bar[XB_TOPGEN], 1u);
            else XB_SPIN(xb_ld(&bar[XB_TOPGEN]) == tg, bar);
            __builtin_amdgcn_fence(__ATOMIC_ACQUIRE, "agent");
            xb_add(&bar[XB_XGEN(b.x)], 1u);
            asm volatile("s_waitcnt vmcnt(0)" ::: "memory");
        } else {
            XB_SPIN(xb_ld(&bar[XB_XGEN(b.x)]) == gen, bar);
            __builtin_amdgcn_fence(__ATOMIC_ACQUIRE, "agent");
            asm volatile("s_waitcnt vmcnt(0)" ::: "memory");
        }
    }
    __syncthreads();
}
struct Frame {
    LAS unsigned char* lds;
    volatile LAS unsigned* MISC;
    gu32* ctl;
    int tid, lane, wave;
    int vcu, G;
};
__device__ __forceinline__ float wave_sum(float v) {
#pragma unroll
    for (int o = 1; o < 64; o <<= 1) v += __shfl_xor(v, o);
    return v;
}
__device__ __forceinline__ float wave_max(float v) {
#pragma unroll
    for (int o = 1; o < 64; o <<= 1) v = fmaxf(v, __shfl_xor(v, o));
    return v;
}

__device__ __forceinline__ void conv_item(const float* W, int K, int N, const float* gain, bf16* WT, int drow0, int k0, int n0, LAS float* scr, int lane) {
    const int kr = lane >> 4, c4 = lane & 15;
    f32x4 v[16];
#pragma unroll
    for (int i = 0; i < 16; ++i) v[i] = __builtin_nontemporal_load((const GAS f32x4*)(W + (size_t)(k0 + 4 * i + kr) * N + n0 + 4 * c4));
#pragma unroll
    for (int i = 0; i < 16; ++i) { const int k = 4 * i + kr; *(LAS f32x4*)(scr + k * 64 + ((4 * c4) ^ (((k >> 3) & 7) << 2))) = v[i]; }
    LDS_WAIT(); asm volatile("" ::: "memory");
    const int c = lane & 7;
    f32x4 g0 = (f32x4){1.f, 1.f, 1.f, 1.f}, g1 = g0;
    if (gain) { g0 = *(const GAS f32x4*)(gain + k0 + 8 * c); g1 = *(const GAS f32x4*)(gain + k0 + 8 * c + 4); }
#pragma unroll
    for (int j = 0; j < 8; ++j) { const int n = (lane >> 3) + 8 * j; const LAS float* s = scr + (8 * c) * 64 + (n ^ (c << 2));
        v4u o; o.x = pk2(s[0 * 64] * g0[0], s[1 * 64] * g0[1]); o.y = pk2(s[2 * 64] * g0[2], s[3 * 64] * g0[3]); o.z = pk2(s[4 * 64] * g1[0], s[5 * 64] * g1[1]); o.w = pk2(s[6 * 64] * g1[2], s[7 * 64] * g1[3]);
        *(GAS v4u*)(WT + pg8::tofs(drow0 + n, k0 + 8 * c, K)) = o; }
    LDS_WAIT(); asm volatile("" ::: "memory");
}
template <int MODE> __device__ __forceinline__ void conv_matrix(Frame& F, const float* W, int K, int N, const float* gain, bf16* WT, int& base, int wk, int NW) {
    LAS float* scr = (LAS float*)(F.lds + RING_OFF + F.wave * 16384);
    const int nblk = N / 64, nitems = (K / 64) * nblk;
    int it = wk - (base % NW); if (it < 0) it += NW;
    for (; it < nitems; it += NW) { const int kb = it / nblk, nb = it % nblk, n0 = nb * 64;
        const int drow0 = MODE == 0 ? n0 : (256 * (n0 >> 7) + (n0 & 127) + (MODE == 2 ? 128 : 0));
        conv_item(W, K, N, gain, WT, drow0, kb * 64, n0, scr, F.lane); }
    base += nitems;
}
__device__ __forceinline__ void row_to_bf16_rstd(const float* xrow, bf16* XBt, int m, float* rstd_out, int lane) {
    const GAS f32x4* xr = (const GAS f32x4*)xrow + lane;
    f32x4 v[16]; float s = 0.f;
#pragma unroll
    for (int j = 0; j < 16; ++j) { v[j] = xr[64 * j]; s += (v[j].x * v[j].x + v[j].y * v[j].y) + (v[j].z * v[j].z + v[j].w * v[j].w); }
    const float tot = wave_sum(s);
#pragma unroll
    for (int j = 0; j < 16; ++j) { v2u w; w.x = pk2(v[j].x, v[j].y); w.y = pk2(v[j].z, v[j].w); *(GAS v2u*)(XBt + pg8::tofs(m, 256 * j + 4 * lane, DM)) = w; }
    if (lane == 0) *rstd_out = 1.0f / sqrtf(tot * (1.0f / DM) + EPS);
}
struct Ptrs {
    const float* in[15]; float* out; unsigned char* ws;
};
__device__ __forceinline__ void p0_prologue(Frame& F, const Ptrs& A) {
    unsigned char* ws = A.ws;
    int base = 0; const int wk0 = F.vcu * NWAVES + F.wave, NW0 = F.G * NWAVES;
    conv_matrix<1>(F, A.in[2], DM, DFF, A.in[1], (bf16*)(ws + WS_WGU1), base, wk0, NW0);
    conv_matrix<2>(F, A.in[3], DM, DFF, A.in[1], (bf16*)(ws + WS_WGU1), base, wk0, NW0);
#if !MK_WIN_LATE
    conv_matrix<0>(F, A.in[6], DM, NIN, A.in[5], (bf16*)(ws + WS_WIN), base, wk0, NW0);
#endif
    const int gw = F.vcu * NWAVES + F.wave, NGW = F.G * NWAVES;
    for (int m = gw; m < M; m += NGW) row_to_bf16_rstd(A.in[0] + (size_t)m * DM, (bf16*)(ws + WS_XB), m, (float*)(ws + WS_RSTD) + m, F.lane);
    float* rc = (float*)(ws + WS_ROPEC); float* rsn = (float*)(ws + WS_ROPES);
    for (int e = blockIdx.x * (NWAVES * 64) + F.tid; e < SEQ * 128; e += F.G * NWAVES * 64) { const int pos = e >> 7, i = e & 127;
        double p = 1.0, b = 0.930572040929699;
#pragma unroll
        for (int bit = 0; bit < 7; ++bit) { if ((i >> bit) & 1) p *= b; b *= b; }
        const float ang = (float)pos * (float)p;
        double t = (double)ang * 0.15915494309189535; t -= __builtin_rint(t);
        const float r = (float)(t * 6.283185307179586);
        rc[e] = cosf(r); rsn[e] = sinf(r); }
}
template <int JOB> __device__ __forceinline__ void tail_convert(Frame& F, const Ptrs& A, int first) {
    if ((int)blockIdx.x < first) return;
    if (JOB == 4) { int base4 = 0; conv_matrix<0>(F, A.in[6], DM, NIN, A.in[5], (bf16*)(A.ws + WS_WIN), base4, ((int)blockIdx.x - first) * NWAVES + F.wave, (F.G - first) * NWAVES); return; }
    unsigned char* ws = A.ws; int base = 0; const int wk = ((int)blockIdx.x - first) * NWAVES + F.wave, NW = (F.G - first) * NWAVES;
    if (JOB == 1) conv_matrix<0>(F, A.in[4], DFF, DM, nullptr, (bf16*)(ws + WS_WD1), base, wk, NW);
    if (JOB == 2) { conv_matrix<0>(F, A.in[7], RW, DM, nullptr, (bf16*)(ws + WS_WOA), base, wk, NW);
        conv_matrix<0>(F, A.in[8], AOW, DM, nullptr, (bf16*)(ws + WS_WOB), base, wk, NW);
        conv_matrix<0>(F, A.in[9], DM, DM, nullptr, (bf16*)(ws + WS_WO), base, wk, NW);
        conv_matrix<1>(F, A.in[11], DM, DFF, A.in[10], (bf16*)(ws + WS_WGU2), base, wk, NW);
        conv_matrix<2>(F, A.in[12], DM, DFF, A.in[10], (bf16*)(ws + WS_WGU2), base, wk, NW); }
    if (JOB == 3) conv_matrix<0>(F, A.in[13], DFF, DM, nullptr, (bf16*)(ws + WS_WD2), base, wk, NW);
}
__device__ __forceinline__ void reduce_rstd(Frame& F, const float* part, float* rstd) {
    const int gw = F.vcu * NWAVES + F.wave, NGW = F.G * NWAVES;
    for (int m = gw; m < M; m += NGW) { const float tot = wave_sum(part[(size_t)m * 64 + F.lane]); if (F.lane == 0) rstd[m] = 1.0f / sqrtf(tot * (1.0f / DM) + EPS); }
}
__device__ __forceinline__ void final_norm(Frame& F, float* out, const float* part, const float* gain) {
    const int gw = F.vcu * NWAVES + F.wave, NGW = F.G * NWAVES;
    for (int m = gw; m < M; m += NGW) { const float tot = wave_sum(part[(size_t)m * 64 + F.lane]); const float rs = 1.0f / sqrtf(tot * (1.0f / DM) + EPS);
        GAS f32x4* xr = (GAS f32x4*)(out + (size_t)m * DM) + F.lane; const GAS f32x4* gr = (const GAS f32x4*)gain + F.lane;
        f32x4 v[16];
#pragma unroll
        for (int j = 0; j < 16; ++j) v[j] = xr[64 * j];
#pragma unroll
        for (int j = 0; j < 16; ++j) xr[64 * j] = v[j] * rs * gr[64 * j]; }
}

__device__ __forceinline__ void naive_attn(Frame& F, const bf16* P, bf16* YB) {
    LAS float* qf = (LAS float*)(F.lds);
    LAS float* sc = qf + 384;
    LAS float* red = sc + 400;
    const int t = F.tid;
    for (int uidx = blockIdx.x; uidx < M * 4; uidx += F.G) {
        const int row = uidx >> 2, hi = uidx & 3, b = row >> 11, s = row & 2047;
        if (t < 384) { const int g = t >> 7, d = t & 127; qf[t] = bf2f(P[(size_t)row * NIN + C_QA + (4 * g + hi) * 128 + d]); }
        __syncthreads();
        if (t < 387) { const int g = t / 129, kk = t % 129, r = g == 0 ? 1 : (g == 1 ? 4 : 16), pos = s - kk * r; float a = -1e30f;
            if (pos >= 0) { const bf16* kp = P + (size_t)(b * SEQ + pos) * NIN + C_KA + (4 * g + hi) * 128; a = 0.f;
                for (int d = 0; d < 128; ++d) a += qf[g * 128 + d] * bf2f(kp[d]); }
            sc[t] = a; }
        __syncthreads();
        float mx = -1e30f; for (int k = 0; k < 387; ++k) mx = fmaxf(mx, sc[k]);
        float den = 0.f; for (int k = 0; k < 387; ++k) den += __builtin_amdgcn_exp2f(sc[k] - mx);
        { const int d = t & 127, part = t >> 7; float y = 0.f;
          for (int k = part * 97; k < (part + 1) * 97 && k < 387; ++k) { const int g = k / 129, kk = k % 129, r = g == 0 ? 1 : (g == 1 ? 4 : 16), pos = s - kk * r;
              if (pos >= 0) y += __builtin_amdgcn_exp2f(sc[k] - mx) * bf2f(P[(size_t)(b * SEQ + pos) * NIN + C_VA + (4 * g + hi) * 128 + d]); }
          red[part * 128 + d] = y; }
        __syncthreads();
        if (t < 128) { const float y = (red[t] + red[128 + t]) + (red[256 + t] + red[384 + t]); YB[pg8::tofs(row, hi * 128 + t, AOW)] = (bf16)f2bf(y / den); }
        __syncthreads();
    }
}
__device__ __forceinline__ void naive_ret(Frame& F, const bf16* P, bf16* YR) {
    LAS float* qf = (LAS float*)(F.lds);
    LAS float* sc = qf + 256;
    LAS float* red = sc + 2048;
    LAS float* wsum = red + 512;
    const int t = F.tid;
    for (int uidx = blockIdx.x; uidx < M * RH; uidx += F.G) {
        const int row = uidx >> 3, h = uidx & 7, b = row >> 11, s = row & 2047;
        const float l2g = __builtin_log2f(1.0f - __builtin_amdgcn_exp2f(-5.0f - (float)h));
        if (t < 256) qf[t] = bf2f(P[(size_t)row * NIN + C_QR + h * 256 + t]);
        __syncthreads();
        for (int j = t; j <= s; j += 512) { const bf16* kp = P + (size_t)(b * SEQ + j) * NIN + C_KR + h * 256; float a = 0.f;
            for (int d = 0; d < 256; ++d) a += qf[d] * bf2f(kp[d]);
            sc[j] = a * __builtin_amdgcn_exp2f(l2g * (float)(s - j)); }
        __syncthreads();
        { const int e = t & 255, half = t >> 8; float o = 0.f; const bf16* vp = P + (size_t)(b * SEQ) * NIN + C_VR + h * 256 + e;
          for (int j = half; j <= s; j += 2) o += sc[j] * bf2f(vp[(size_t)j * NIN]);
          red[half * 256 + e] = o; }
        __syncthreads();
        float o = 0.f, ss = 0.f;
        if (t < 256) { o = red[t] + red[256 + t]; ss = o * o; }
        ss = wave_sum(ss); if (F.lane == 0) wsum[F.wave] = ss;
        __syncthreads();
        if (t < 256) { const float tot = (wsum[0] + wsum[1]) + (wsum[2] + wsum[3]); const float rs = 1.0f / sqrtf(tot * (1.0f / 256.0f) + EPS);
            const float gt = bf2f(P[(size_t)row * NIN + C_GR + h * 256 + t]);
            YR[pg8::tofs(row, h * 256 + t, RW)] = (bf16)f2bf(gt * (o * rs)); }
        __syncthreads();
    }
}
typedef short v4i16_t __attribute__((ext_vector_type(4)));
__device__ __forceinline__ bf16x8 tr_pair(const LAS unsigned char* p0, const LAS unsigned char* p1) {
    const v4i16_t lo = __builtin_amdgcn_ds_read_tr16_b64_v4i16((LAS v4i16_t*)p0), hi = __builtin_amdgcn_ds_read_tr16_b64_v4i16((LAS v4i16_t*)p1);
    return __builtin_shufflevector(lo, hi, 0, 1, 2, 3, 4, 5, 6, 7);
}
template <int D> __device__ __forceinline__ unsigned tile_toff(size_t stride, int tid) { constexpr int PPR = D / 8; return (unsigned)((size_t)(tid / PPR) * stride * 2 + (size_t)(tid % PPR) * 16); }
template <int D> __device__ __forceinline__ void tile_load(v4u (&r)[D / 64], const bf16* base, size_t stride, unsigned toff) {
    constexpr int PPR = D / 8;
#pragma unroll
    for (int i = 0; i < D / 64; ++i) r[i] = *(const GAS v4u*)((const char*)base + (size_t)i * (512 / PPR) * stride * 2 + toff);
}
template <int D, int STR> __device__ __forceinline__ void tile_store(LAS unsigned char* buf, const v4u (&r)[D / 64], int tid) {
    constexpr int PPR = D / 8; LAS unsigned char* p0 = buf + (tid / PPR) * STR + (tid % PPR) * 16;
#pragma unroll
    for (int i = 0; i < D / 64; ++i) *(LAS v4u*)(p0 + i * (512 / PPR) * STR) = r[i];
}
template <int DK, int KSTR> __device__ __forceinline__ void st_compute(f32x4 (&st)[4], const LAS unsigned char* Kb, const bf16x8 (&qf)[DK / 32], int lane) {
    const LAS unsigned char* kp = Kb + (lane & 15) * KSTR + (lane >> 4) * 16;
    bf16x8 kf[2][4];
#pragma unroll
    for (int kg = 0; kg < 4; ++kg) { kf[0][kg] = *(const LAS bf16x8*)(kp + kg * 16 * KSTR); st[kg] = (f32x4){0.f, 0.f, 0.f, 0.f}; }
#pragma unroll
    for (int ks = 0; ks < DK / 32; ++ks) {
        if (ks + 1 < DK / 32) {
#pragma unroll
            for (int kg = 0; kg < 4; ++kg) kf[(ks + 1) & 1][kg] = *(const LAS bf16x8*)(kp + kg * 16 * KSTR + (ks + 1) * 64); }
        __builtin_amdgcn_sched_barrier(0);
#pragma unroll
        for (int kg = 0; kg < 4; ++kg) st[kg] = __builtin_amdgcn_mfma_f32_16x16x32_bf16(kf[ks & 1][kg], qf[ks], st[kg], 0, 0, 0);
        __builtin_amdgcn_sched_barrier(0);
    }
}
template <int DV, int VSTR> __device__ __forceinline__ void pv_compute(f32x4 (&of)[DV / 16], const LAS unsigned char* Vb, const f32x4 (&p)[4], int lane) {
    const LAS unsigned char* vp = Vb + (4 * (lane >> 4) + ((lane & 15) >> 2)) * VSTR + (lane & 3) * 8;
    bf16x8 pf[2];
#pragma unroll
    for (int s = 0; s < 2; ++s) { v4u w; w.x = pg8::cvt_pk_bf16(p[2 * s][0], p[2 * s][1]); w.y = pg8::cvt_pk_bf16(p[2 * s][2], p[2 * s][3]); w.z = pg8::cvt_pk_bf16(p[2 * s + 1][0], p[2 * s + 1][1]); w.w = pg8::cvt_pk_bf16(p[2 * s + 1][2], p[2 * s + 1][3]);
        pf[s] = __builtin_bit_cast(bf16x8, w); }
    constexpr int GPS = DV / 64, NB = 2 * GPS;
    bf16x8 vf[2][4];
#pragma unroll
    for (int j = 0; j < 4; ++j) { const LAS unsigned char* a0 = vp + j * 32; vf[0][j] = tr_pair(a0, a0 + 16 * VSTR); }
#pragma unroll
    for (int b = 0; b < NB; ++b) {
        if (b + 1 < NB) { const int s1 = (b + 1) / GPS, g1 = 4 * ((b + 1) % GPS);
#pragma unroll
            for (int j = 0; j < 4; ++j) { const LAS unsigned char* a0 = vp + (32 * s1) * VSTR + (g1 + j) * 32; vf[(b + 1) & 1][j] = tr_pair(a0, a0 + 16 * VSTR); } }
        __builtin_amdgcn_sched_barrier(0);
        const int s = b / GPS, g0 = 4 * (b % GPS);
#pragma unroll
        for (int j = 0; j < 4; ++j) of[g0 + j] = __builtin_amdgcn_mfma_f32_16x16x32_bf16(vf[b & 1][j], pf[s], of[g0 + j], 0, 0, 0);
        __builtin_amdgcn_sched_barrier(0);
    }
}
constexpr int MIX_LDS_BYTES = 2 * (64 * (2 * 256 + 16) + 64 * (2 * 256 + 32));

__device__ __forceinline__ void ret_unit(Frame& F, const bf16* P, bf16* YR, int b, int h, int n) {
    constexpr int KSTR = 2 * RD + 32, VSTR = 2 * RD + 32, KBUF = 64 * KSTR, BUF = KBUF + 64 * VSTR;
    const int lane = F.lane, w = F.wave, kr = lane & 15, quad = lane >> 4, tid = F.tid;
    const float l2g = __builtin_log2f(1.0f - __builtin_amdgcn_exp2f(-5.0f - (float)h));
    const size_t rowq = (size_t)b * SEQ + 128 * n + 16 * w + kr;
    const bf16* kbase = P + (size_t)b * SEQ * NIN + C_KR + h * RD; const bf16* vbase = P + (size_t)b * SEQ * NIN + C_VR + h * RD;
    bf16x8 qf[RD / 32];
#pragma unroll
    for (int ks = 0; ks < RD / 32; ++ks) qf[ks] = *(const GAS bf16x8*)(P + rowq * NIN + C_QR + h * RD + 32 * ks + 8 * quad);
    f32x4 of[RD / 16];
#pragma unroll
    for (int i = 0; i < RD / 16; ++i) of[i] = (f32x4){0.f, 0.f, 0.f, 0.f};
    const int nsc = 2 * (n + 1); const float qi = (float)(128 * n + 16 * w + kr);
    float cr[4], gk[4];
#pragma unroll
    for (int r = 0; r < 4; ++r) { cr[r] = __builtin_amdgcn_exp2f(-l2g * (float)(4 * quad + r)); gk[r] = __uint_as_float(__builtin_amdgcn_readfirstlane(__float_as_uint(__builtin_amdgcn_exp2f(-l2g * (float)(16 * r))))); }
    v4u rk[RD / 64], rv[RD / 64];
    const unsigned toff = tile_toff<RD>(NIN, tid);
    tile_load<RD>(rk, kbase, NIN, toff); tile_load<RD>(rv, vbase, NIN, toff);
    tile_store<RD, KSTR>(F.lds, rk, tid); tile_store<RD, VSTR>(F.lds + KBUF, rv, tid);
    __syncthreads();
    for (int sc = 0; sc < nsc; ++sc) {
        const LAS unsigned char* Kb = F.lds + (sc & 1) * BUF; LAS unsigned char* Nb = F.lds + ((sc + 1) & 1) * BUF;
        const bool more = sc + 1 < nsc;
        if (more) { tile_load<RD>(rk, kbase + (size_t)(64 * (sc + 1)) * NIN, NIN, toff); tile_load<RD>(rv, vbase + (size_t)(64 * (sc + 1)) * NIN, NIN, toff); }
        f32x4 st[4];
        st_compute<RD, KSTR>(st, Kb, qf, lane);
        const float aq = __builtin_amdgcn_exp2f(l2g * (qi - (float)(64 * sc)));
        if (sc >= 2 * n) {
            const float d0 = qi - (float)(64 * sc + 4 * quad);
#pragma unroll
            for (int kg = 0; kg < 4; ++kg)
#pragma unroll
                for (int r = 0; r < 4; ++r) { const float d = d0 - (float)(16 * kg + r); st[kg][r] = d >= 0.f ? st[kg][r] * ((aq * gk[kg]) * cr[r]) : 0.f; }
        } else {
#pragma unroll
            for (int kg = 0; kg < 4; ++kg)
#pragma unroll
                for (int r = 0; r < 4; ++r) st[kg][r] = st[kg][r] * ((aq * gk[kg]) * cr[r]);
        }
        pv_compute<RD, VSTR>(of, Kb + KBUF, st, lane);
        if (more) { tile_store<RD, KSTR>(Nb, rk, tid); tile_store<RD, VSTR>(Nb + KBUF, rv, tid); }
        __syncthreads();
    }
    float ss = 0.f;
#pragma unroll
    for (int i = 0; i < RD / 16; ++i) ss += (of[i][0] * of[i][0] + of[i][1] * of[i][1]) + (of[i][2] * of[i][2] + of[i][3] * of[i][3]);
    ss += __shfl_xor(ss, 16); ss += __shfl_xor(ss, 32);
    const float rs = 1.0f / sqrtf(ss * (1.0f / RD) + EPS);
    const bf16* gp = P + rowq * NIN + C_GR + h * RD + 4 * quad;
#pragma unroll
    for (int i = 0; i < RD / 16; ++i) { const v2u gw = *(const GAS v2u*)(gp + 16 * i);
        v2u o; o.x = pg8::cvt_pk_bf16(bflo(gw.x) * (of[i][0] * rs), bfhi(gw.x) * (of[i][1] * rs)); o.y = pg8::cvt_pk_bf16(bflo(gw.y) * (of[i][2] * rs), bfhi(gw.y) * (of[i][3] * rs));
        *(GAS v2u*)(YR + pg8::tofs((int)rowq, h * RD + 4 * quad + 16 * i, RW)) = o; }
}
__device__ __forceinline__ void ret_phase(Frame& F, const bf16* P, bf16* YR) {
    for (int up = blockIdx.x; up < BATCH * RH * 8; up += F.G) { const int np = up & 7, h = (up >> 3) & 7, b = up >> 6;
        ret_unit(F, P, YR, b, h, 15 - np); ret_unit(F, P, YR, b, h, np); }
}
__device__ __forceinline__ void attn_unit(Frame& F, const bf16* P, bf16* OB, float* LSE, int b, int g, int hi, int c, int n) {
    constexpr int KSTR = 2 * AD + 32, VSTR = 2 * AD + 32, KBUF = 64 * KSTR, BUF = KBUF + 64 * VSTR;
    const int lane = F.lane, w = F.wave, kr = lane & 15, quad = lane >> 4, tid = F.tid;
    const int r = g == 0 ? 1 : (g == 1 ? 4 : 16), hd = 4 * g + hi;
    const int uq = 128 * n + 16 * w + kr;
    const size_t rowq = (size_t)b * SEQ + (size_t)uq * r + c;
    const int ub0 = n > 0 ? 128 * (n - 1) : 0;
    const size_t kstride = (size_t)r * NIN;
    const bf16* kbase = P + ((size_t)b * SEQ + (size_t)ub0 * r + c) * NIN + C_KA + hd * AD; const bf16* vbase = kbase + (C_VA - C_KA);
    bf16x8 qf[AD / 32];
#pragma unroll
    for (int ks = 0; ks < AD / 32; ++ks) qf[ks] = *(const GAS bf16x8*)(P + rowq * NIN + C_QA + hd * AD + 32 * ks + 8 * quad);
    f32x4 of[AD / 16];
#pragma unroll
    for (int i = 0; i < AD / 16; ++i) of[i] = (f32x4){0.f, 0.f, 0.f, 0.f};
    float mrun = -1e30f, den = 0.f;
    const int nsc = n > 0 ? 4 : 2;
    v4u rk[AD / 64], rv[AD / 64];
    const unsigned toff = tile_toff<AD>(kstride, tid);
    tile_load<AD>(rk, kbase, kstride, toff); tile_load<AD>(rv, vbase, kstride, toff);
    tile_store<AD, KSTR>(F.lds, rk, tid); tile_store<AD, VSTR>(F.lds + KBUF, rv, tid);
    __syncthreads();
    for (int sc = 0; sc < nsc; ++sc) {
        const LAS unsigned char* Kb = F.lds + (sc & 1) * BUF; LAS unsigned char* Nb = F.lds + ((sc + 1) & 1) * BUF;
        const bool more = sc + 1 < nsc;
        if (more) { tile_load<AD>(rk, kbase + (size_t)(64 * (sc + 1)) * kstride, kstride, toff); tile_load<AD>(rv, vbase + (size_t)(64 * (sc + 1)) * kstride, kstride, toff); }
        f32x4 st[4];
        st_compute<AD, KSTR>(st, Kb, qf, lane);
        const int dq = uq - (ub0 + 64 * sc + 4 * quad);
        float mx = -1e30f;
#pragma unroll
        for (int kg = 0; kg < 4; ++kg)
#pragma unroll
            for (int q = 0; q < 4; ++q) { const int d = dq - (16 * kg + q); const bool ok = d >= 0 && d <= 128; st[kg][q] = ok ? st[kg][q] : -1e30f; mx = fmaxf(mx, st[kg][q]); }
        mx = fmaxf(mx, __shfl_xor(mx, 16)); mx = fmaxf(mx, __shfl_xor(mx, 32));
        const float mnew = fmaxf(mrun, mx), alpha = __builtin_amdgcn_exp2f(mrun - mnew); mrun = mnew;
        float rsum = 0.f;
#pragma unroll
        for (int kg = 0; kg < 4; ++kg)
#pragma unroll
            for (int q = 0; q < 4; ++q) { const float pv = st[kg][q] > -1e29f ? __builtin_amdgcn_exp2f(st[kg][q] - mnew) : 0.f; st[kg][q] = pv; rsum += pv; }
        rsum += __shfl_xor(rsum, 16); rsum += __shfl_xor(rsum, 32);
        den = den * alpha + rsum;
#pragma unroll
        for (int i = 0; i < AD / 16; ++i) of[i] = of[i] * alpha;
        pv_compute<AD, VSTR>(of, Kb + KBUF, st, lane);
        if (more) { tile_store<AD, KSTR>(Nb, rk, tid); tile_store<AD, VSTR>(Nb + KBUF, rv, tid); }
        __syncthreads();
    }
    const float inv = 1.0f / den;
    bf16* op = OB + rowq * AW + hd * AD + 4 * quad;
#pragma unroll
    for (int i = 0; i < AD / 16; ++i) { v2u o; o.x = pg8::cvt_pk_bf16(of[i][0] * inv, of[i][1] * inv); o.y = pg8::cvt_pk_bf16(of[i][2] * inv, of[i][3] * inv); *(GAS v2u*)(op + 16 * i) = o; }
    if (quad == 0) LSE[rowq * AHT + hd] = mrun + __builtin_log2f(den);
}
__device__ __forceinline__ void attn_phase(Frame& F, const bf16* P, bf16* OB, float* LSE) {
    for (int u = blockIdx.x; u < 768; u += F.G) { const int g = u >> 8, v = u & 255, b = v >> 6, hi = (v >> 4) & 3, x = v & 15;
        const int c = g == 0 ? 0 : (g == 1 ? (x >> 2) : x), n = g == 0 ? x : (g == 1 ? (x & 3) : 0);
        attn_unit(F, P, OB, LSE, b, g, hi, c, n); }
}
__device__ __forceinline__ void attn_merge(Frame& F, const bf16* OB, const float* LSE, bf16* YB) {
    for (int e = blockIdx.x * (NWAVES * 64) + F.tid; e < M * 4 * 16; e += F.G * NWAVES * 64) { const int row = e >> 6, hi = (e >> 4) & 3, ch = e & 15;
        const float l0 = LSE[row * AHT + hi], l1 = LSE[row * AHT + 4 + hi], l2 = LSE[row * AHT + 8 + hi], mx = fmaxf(l0, fmaxf(l1, l2));
        float w0 = __builtin_amdgcn_exp2f(l0 - mx), w1 = __builtin_amdgcn_exp2f(l1 - mx), w2 = __builtin_amdgcn_exp2f(l2 - mx); const float inv = 1.0f / (w0 + w1 + w2); w0 *= inv; w1 *= inv; w2 *= inv;
        const bf16* op = OB + (size_t)row * AW + hi * AD + ch * 8;
        const v4u a = *(const GAS v4u*)op, bq = *(const GAS v4u*)(op + 4 * AD), cq = *(const GAS v4u*)(op + 8 * AD);
        v4u o;
        o.x = pg8::cvt_pk_bf16(w0 * bflo(a.x) + w1 * bflo(bq.x) + w2 * bflo(cq.x), w0 * bfhi(a.x) + w1 * bfhi(bq.x) + w2 * bfhi(cq.x));
        o.y = pg8::cvt_pk_bf16(w0 * bflo(a.y) + w1 * bflo(bq.y) + w2 * bflo(cq.y), w0 * bfhi(a.y) + w1 * bfhi(bq.y) + w2 * bfhi(cq.y));
        o.z = pg8::cvt_pk_bf16(w0 * bflo(a.z) + w1 * bflo(bq.z) + w2 * bflo(cq.z), w0 * bfhi(a.z) + w1 * bfhi(bq.z) + w2 * bfhi(cq.z));
        o.w = pg8::cvt_pk_bf16(w0 * bflo(a.w) + w1 * bflo(bq.w) + w2 * bflo(cq.w), w0 * bfhi(a.w) + w1 * bfhi(bq.w) + w2 * bfhi(cq.w));
        *(GAS v4u*)(YB + pg8::tofs(row, hi * AD + ch * 8, AOW)) = o; }
}
struct Args { Ptrs p; int ph_lo, ph_hi; };
__global__ void __launch_bounds__(NWAVES * 64, 2) mk_fwd(Args args) {
    extern __shared__ __attribute__((aligned(16))) unsigned char lds[];
    Frame F;
    F.lds = (LAS unsigned char*)lds;
    F.MISC = (volatile LAS unsigned*)(F.lds + MISC_OFF);
    F.tid = threadIdx.x; F.lane = F.tid & 63; F.wave = __builtin_amdgcn_readfirstlane(F.tid >> 6);
    F.G = gridDim.x; { const int bx = blockIdx.x; F.vcu = (F.G % 8 == 0) ? (bx % 8) * (F.G / 8) + bx / 8 : bx; }
    unsigned char* ws = args.p.ws;
    F.ctl = (gu32*)(ws + WS_CTL);
    for (int u = F.tid; u < (LDS_BYTES - LDSCTL_OFF) / 4; u += NWAVES * 64) ((LAS unsigned*)(F.lds + LDSCTL_OFF))[u] = 0u;
    __syncthreads();
#if MK_PER_PHASE
#define GRID_BAR() do { } while (0)
#else
    XcdBarrier bar = xcd_barrier_post((unsigned*)(F.ctl + CW_BAR), F.MISC + 8);
#define GRID_BAR() xcd_barrier(bar)
#endif
    const int lo = args.ph_lo, hi = args.ph_hi;
#define IN(k) (lo <= (k) && (k) < hi)
#define REPEAT(k) _Pragma("unroll") for (int rep_ = 0; rep_ < ((MK_REPEAT_PHASE == (k)) ? 2 : 1); ++rep_)
#define SEAM(k) do { if (IN(k) && IN((k) + 1)) GRID_BAR(); } while (0)
    const float* x = args.p.in[0]; float* out = args.p.out;
    bf16* XB = (bf16*)(ws + WS_XB); bf16* HB = (bf16*)(ws + WS_H); bf16* PB = (bf16*)(ws + WS_P); bf16* YR = (bf16*)(ws + WS_YR); bf16* OB = (bf16*)(ws + WS_OB); bf16* YB = (bf16*)(ws + WS_YB);
    bf16* MG = (bf16*)(ws + WS_MG); bf16* TB = (bf16*)(ws + WS_T); float* rstd = (float*)(ws + WS_RSTD); float* part = (float*)(ws + WS_PART); float* lse = (float*)(ws + WS_LSE);
    const float* ropec = (const float*)(ws + WS_ROPEC); const float* ropes = (const float*)(ws + WS_ROPES);
    (void)OB; (void)lse;

    if (IN(0)) REPEAT(0) { p0_prologue(F, args.p); } SEAM(0);
    if (IN(1)) REPEAT(1) { pg8::Gemm g{XB, (const bf16*)(ws + WS_WGU1), M, NGU, DM}; pg8::StaticOrder S; S.init(M, NGU, F.G, (int)blockIdx.x);
        pg8::EpiSwiGLU E{HB, DFF, rstd};
        pg8::gemm_phase<pg8::EpiSwiGLU, pg8::StaticOrder, true, true>(F.lds + RING_OFF, g, S, E);
        if (rep_ == 0) tail_convert<1>(F, args.p, ((M / 256) * (NGU / 256)) % F.G); } SEAM(1);
    if (IN(2)) REPEAT(2) { pg8::Gemm g{HB, (const bf16*)(ws + WS_WD1), M, DM, DFF}; pg8::PanelOrder S; S.init(M, DM, F.G, (int)blockIdx.x);
        pg8::EpiResid<false> E{x, nullptr, XB, part, DM, 0.5f};
        pg8::gemm_phase<pg8::EpiResid<false>, pg8::PanelOrder, true, true>(F.lds + RING_OFF, g, S, E); } SEAM(2);
#if MK_NULL_PROBE == 2
    if (IN(2)) { pg8::Gemm g{HB, (const bf16*)(ws + WS_WD1), M, DM, DFF}; pg8::PanelOrder S; S.init(M, DM, F.G, (int)blockIdx.x);
        pg8::EpiNull E{(float*)TB};
        pg8::gemm_phase<pg8::EpiNull, pg8::StaticOrder, true, true>(F.lds + RING_OFF, g, S, E); GRID_BAR(); }
#elif MK_NULL_PROBE == 5
    if (IN(2)) { const unsigned long long t0 = __builtin_amdgcn_s_memrealtime(); while (__builtin_amdgcn_s_memrealtime() - t0 < 30000ull) __builtin_amdgcn_s_sleep(64); GRID_BAR(); }
#elif MK_NULL_PROBE == 4
    if (IN(2)) { pg8::Gemm g{(const bf16*)(ws + WS_T + 64 * MiB), (const bf16*)(ws + WS_T + 68 * MiB), M, NGU, DM}; pg8::SameUnitOrder S;
        pg8::EpiNull E{(float*)TB};
        pg8::gemm_phase<pg8::EpiNull, pg8::SameUnitOrder, true, true>(F.lds + RING_OFF, g, S, E); GRID_BAR(); }
#elif MK_NULL_PROBE == 3
    if (IN(2)) { pg8::Gemm g{XB, (const bf16*)(ws + WS_WGU1), M, NGU, DM}; pg8::SameUnitOrder S;
        pg8::EpiNull E{(float*)TB};
        pg8::gemm_phase<pg8::EpiNull, pg8::SameUnitOrder, true, true>(F.lds + RING_OFF, g, S, E); GRID_BAR(); }
#elif MK_NULL_PROBE == 1
    if (IN(2)) { pg8::Gemm g{XB, (const bf16*)(ws + WS_WGU1), M, NGU, DM}; pg8::StaticOrder S; S.init(M, NGU, F.G, (int)blockIdx.x);
        pg8::EpiNull E{(float*)TB};
        pg8::gemm_phase<pg8::EpiNull, pg8::StaticOrder, true, true>(F.lds + RING_OFF, g, S, E); GRID_BAR(); }
#endif
    if (IN(3)) REPEAT(3) { reduce_rstd(F, part, rstd + M);
#if MK_WIN_LATE
        tail_convert<4>(F, args.p, 0);
#endif
    } SEAM(3);
    if (IN(4)) REPEAT(4) { pg8::Gemm g{XB, (const bf16*)(ws + WS_WIN), M, NIN, DM}; pg8::StaticOrder S; S.init(M, NIN, F.G, (int)blockIdx.x);
        pg8::EpiInProj E{PB, NIN, rstd + M, ropec, ropes};
        pg8::gemm_phase<pg8::EpiInProj, pg8::StaticOrder, true, true>(F.lds + RING_OFF, g, S, E);
        if (rep_ == 0) tail_convert<2>(F, args.p, ((M / 256) * (NIN / 256)) % F.G); } SEAM(4);
    if (IN(5)) REPEAT(5) {
#if MK_NAIVE_MIX
        naive_attn(F, PB, YB);
#else
        attn_phase(F, PB, OB, lse);
#endif
    } SEAM(5);
    if (IN(6)) REPEAT(6) {
#if MK_NAIVE_MIX
        naive_ret(F, PB, YR);
#else
        ret_phase(F, PB, YR); attn_merge(F, OB, lse, YB);
#endif
    } SEAM(6);
    if (IN(7)) REPEAT(7) {
        { pg8::Gemm g{YB, (const bf16*)(ws + WS_WOB), M, DM, AOW}; pg8::PanelOrder S; S.init(M, DM, F.G, (int)blockIdx.x);
          pg8::EpiGateB E{PB + C_UB, NIN, TB, DM};
          pg8::gemm_phase<pg8::EpiGateB, pg8::PanelOrder, true, true>(F.lds + RING_OFF, g, S, E); }
        { pg8::Gemm g{YR, (const bf16*)(ws + WS_WOA), M, DM, RW}; pg8::PanelOrder S; S.init(M, DM, F.G, (int)blockIdx.x);
          pg8::EpiGateA E{PB + C_UA, NIN, TB, DM, MG, DM};
          pg8::gemm_phase<pg8::EpiGateA, pg8::PanelOrder, true, true>(F.lds + RING_OFF, g, S, E); }
    } SEAM(7);
    if (IN(8)) REPEAT(8) { pg8::Gemm g{MG, (const bf16*)(ws + WS_WO), M, DM, DM}; pg8::PanelOrder S; S.init(M, DM, F.G, (int)blockIdx.x);
        pg8::EpiResid<true> E{XB, nullptr, XB, part, DM, 1.0f};
        pg8::gemm_phase<pg8::EpiResid<true>, pg8::PanelOrder, true, true>(F.lds + RING_OFF, g, S, E); } SEAM(8);
    if (IN(9)) REPEAT(9) { reduce_rstd(F, part, rstd + 2 * M); } SEAM(9);
    if (IN(10)) REPEAT(10) { pg8::Gemm g{XB, (const bf16*)(ws + WS_WGU2), M, NGU, DM}; pg8::StaticOrder S; S.init(M, NGU, F.G, (int)blockIdx.x);
        pg8::EpiSwiGLU E{HB, DFF, rstd + 2 * M};
        pg8::gemm_phase<pg8::EpiSwiGLU, pg8::StaticOrder, true, true>(F.lds + RING_OFF, g, S, E);
        if (rep_ == 0) tail_convert<3>(F, args.p, ((M / 256) * (NGU / 256)) % F.G); } SEAM(10);
    if (IN(11)) REPEAT(11) { pg8::Gemm g{HB, (const bf16*)(ws + WS_WD2), M, DM, DFF}; pg8::PanelOrder S; S.init(M, DM, F.G, (int)blockIdx.x);
        pg8::EpiResid<true> E{XB, out, nullptr, part, DM, 0.5f};
        pg8::gemm_phase<pg8::EpiResid<true>, pg8::PanelOrder, true, true>(F.lds + RING_OFF, g, S, E); } SEAM(11);
    if (IN(12)) REPEAT(12) { final_norm(F, out, part, args.p.in[14]); }
#undef IN
#undef SEAM
}

extern "C" void kernel_launch(void* const* d_in, const int* in_sizes, int n_in, void* d_out, int out_size, void* d_ws, size_t ws_size, hipStream_t stream) {
    static int grid = 0;
    if (grid == 0) {
        if (n_in != 15 || in_sizes[0] != M * DM || out_size != M * DM || ws_size < WS_END) { fprintf(stderr, "kernel_launch: unexpected shapes / workspace (n_in %d, in0 %d, out %d, ws %zu, need %zu); nothing launched\n", n_in, n_in > 0 ? in_sizes[0] : -1, out_size, ws_size, (size_t)WS_END); grid = -1; return; }
        int dev = 0, cus = 0, per_cu = 0;
        if (hipGetDevice(&dev) != hipSuccess || hipDeviceGetAttribute(&cus, hipDeviceAttributeMultiprocessorCount, dev) != hipSuccess) { grid = -1; return; }
        if (hipFuncSetAttribute((const void*)mk_fwd, hipFuncAttributeMaxDynamicSharedMemorySize, LDS_BYTES) != hipSuccess) { fprintf(stderr, "kernel_launch: hipFuncSetAttribute failed\n"); grid = -1; return; }
        if (hipOccupancyMaxActiveBlocksPerMultiprocessor(&per_cu, (const void*)mk_fwd, NWAVES * 64, LDS_BYTES) != hipSuccess || per_cu < 1)
            fprintf(stderr, "kernel_launch: note: occupancy query reports %d workgroups per CU\n", per_cu);
        (void)hipGetLastError();
        grid = cus;
    }
    if (grid < 0) return;
    if (hipMemsetAsync((char*)d_ws + WS_CTL, 0, CTL_ZERO_BYTES, stream) != hipSuccess) { fprintf(stderr, "kernel_launch: hipMemsetAsync failed\n"); return; }
#if MK_NULL_PROBE == 4
    (void)hipMemsetAsync((char*)d_ws + WS_T + 64 * MiB, 0, 8 * MiB, stream);
#endif
    Args a{};
    for (int i = 0; i < 15; ++i) a.p.in[i] = (const float*)d_in[i];
    a.p.out = (float*)d_out; a.p.ws = (unsigned char*)d_ws;
#if MK_PER_PHASE
    for (int li = 0; li < N_PHASES; ++li) { a.ph_lo = li; a.ph_hi = li + 1;
        hipLaunchKernelGGL(mk_fwd, dim3(grid), dim3(NWAVES * 64), LDS_BYTES, stream, a);
        const hipError_t le = hipPeekAtLastError(); if (le != hipSuccess) { fprintf(stderr, "kernel_launch: launch %d failed: %s\n", li, hipGetErrorName(le)); break; } }
#else
    a.ph_lo = 0; a.ph_hi = N_PHASES;
    hipLaunchKernelGGL(mk_fwd, dim3(grid), dim3(NWAVES * 64), LDS_BYTES, stream, a);
    const hipError_t le = hipPeekAtLastError(); if (le != hipSuccess) fprintf(stderr, "kernel_launch: launch failed: %s\n", hipGetErrorName(le));
#endif
}
```

```cpp
#include <hip/hip_runtime.h>
#include <cstdio>
#include <cstdint>
namespace pg8 {
#define PG8_LAS __attribute__((address_space(3)))
typedef unsigned short bf16_t;
typedef short bf16x8 __attribute__((ext_vector_type(8)));
typedef float f32x4 __attribute__((ext_vector_type(4)));
typedef unsigned u32x4 __attribute__((ext_vector_type(4)));
constexpr int BM = 256, BK = 64, HALF = 128, HTB = HALF * BK * 2  , STAGE_BYTES = 8 * HTB, NXCD = 8, WGM = 8;

__host__ __device__ __forceinline__ int lds_byte(int r, int c) { const int st = (r >> 4) * 2 + (c >> 5), rr = r & 15, cc = c & 31, ob = rr * 64 + cc * 2; return st * 1024 + (ob ^ (((ob >> 9) & 1) << 5)); }
__host__ __device__ __forceinline__ void stage_rc(int b, int& R, int& C) { const int st = b / 1024, sb = b % 1024, swz = sb ^ (((sb >> 9) & 1) << 5); R = (st >> 1) * 16 + swz / 64; C = (st & 1) * 32 + (swz % 64) / 2; }
__host__ __device__ __forceinline__ int perm32(int rho) { const int n = rho >> 4, i = rho & 15; return 8 * (i >> 2) + 4 * n + (i & 3); }

struct Unit { int pm, pn; };
struct Gemm { const bf16_t* A; const bf16_t* Bt; int M, N, K; };

struct StaticOrder {
    int nM, nN, nwg, G, c;
    __host__ __device__ void init(int M, int N, int G_, int c_) { nM = M / BM; nN = N / BM; nwg = nM * nN; G = G_; c = c_; }
    __host__ __device__ bool next(int i, Unit& u) const {
        const long L = (long)i * G + c; if (L >= nwg) return false;
        int wgid = (int)L; { const int q = nwg / NXCD, r = nwg % NXCD, xcd = wgid % NXCD, off = wgid / NXCD; wgid = (xcd < r ? xcd * (q + 1) : r * (q + 1) + (xcd - r) * q) + off; }
        const int nig = WGM * nN, gid = wgid / nig, fm = gid * WGM, gsz = (nM - fm) < WGM ? (nM - fm) : WGM;
        u.pm = fm + ((wgid % nig) % gsz); u.pn = (wgid % nig) / gsz; return true;
    }
    __device__ __forceinline__ void a_ready(const Unit&) const {}
    __device__ __forceinline__ void done(const Unit&) const {}
};

__device__ __forceinline__ unsigned cvt_pk_bf16(float lo, float hi) { unsigned r; asm volatile("v_cvt_pk_bf16_f32 %0, %1, %2" : "=v"(r) : "v"(lo), "v"(hi)); return r; }
typedef float f32x2 __attribute__((ext_vector_type(2)));
typedef unsigned u32x2 __attribute__((ext_vector_type(2)));
__host__ __device__ __forceinline__ size_t tofs(int r, int k, int K) { return ((size_t)(r >> 8) * (size_t)(K >> 6) + (size_t)(k >> 6)) * 16384 + (size_t)((r & 255) * 64 + (k & 63)); }
__device__ __forceinline__ float sigm(float v) { return __builtin_amdgcn_rcpf(1.0f + __builtin_amdgcn_exp2f(-1.4426950408889634f * v)); }
__device__ __forceinline__ f32x4 sigm4(f32x4 v) { return (f32x4){sigm(v[0]), sigm(v[1]), sigm(v[2]), sigm(v[3])}; }
__device__ __forceinline__ f32x4 bfx4_lo(u32x4 w) { return (f32x4){__uint_as_float(w.x << 16), __uint_as_float(w.x & 0xffff0000u), __uint_as_float(w.y << 16), __uint_as_float(w.y & 0xffff0000u)}; }
__device__ __forceinline__ f32x4 bfx4_hi(u32x4 w) { return (f32x4){__uint_as_float(w.z << 16), __uint_as_float(w.z & 0xffff0000u), __uint_as_float(w.w << 16), __uint_as_float(w.w & 0xffff0000u)}; }
__device__ __forceinline__ u32x4 pack8(f32x4 a, f32x4 b) { u32x4 w; w.x = cvt_pk_bf16(a[0], a[1]); w.y = cvt_pk_bf16(a[2], a[3]); w.z = cvt_pk_bf16(b[0], b[1]); w.w = cvt_pk_bf16(b[2], b[3]); return w; }

struct EpiSwiGLU {
    static constexpr bool PERM = true, AFTER_DRAIN = false;
    bf16_t* H; int ldh; const float* rstd;
    __device__ __forceinline__ void operator()(const f32x4 (&acc)[2][2][4][2], const Unit& u, int wr, int wc, int fr, int fq) const {
        const int row0 = u.pm * BM + wr * 64 + fr, col0 = u.pn * HALF + wc * 32 + 8 * fq;
        float rs[2][4];
#pragma unroll
        for (int ai = 0; ai < 2; ++ai)
#pragma unroll
            for (int m = 0; m < 4; ++m) rs[ai][m] = rstd[row0 + ai * HALF + m * 16];
#pragma unroll
        for (int ai = 0; ai < 2; ++ai)
#pragma unroll
            for (int m = 0; m < 4; ++m) { const int row = row0 + ai * HALF + m * 16; const float r = rs[ai][m];
                const f32x4 g0 = acc[ai][0][m][0] * r, g1 = acc[ai][0][m][1] * r, u0 = acc[ai][1][m][0] * r, u1 = acc[ai][1][m][1] * r;
                const f32x4 h0 = g0 * sigm4(g0) * u0, h1 = g1 * sigm4(g1) * u1;
                *(u32x4*)(H + tofs(row, col0, ldh)) = pack8(h0, h1); }
    }
};
template <bool BASE_BF16> struct EpiResid {
    static constexpr bool PERM = false, AFTER_DRAIN = false;
    const void* base; float* out; bf16_t* xb; float* part; int ldc; float scale;
    __device__ __forceinline__ void operator()(const f32x4 (&acc)[2][2][4][2], const Unit& u, int wr, int wc, int fr, int fq) const {
        const int row0 = u.pm * BM + wr * 64 + fr, col0 = u.pn * BM + wc * 32 + 4 * fq;
#pragma unroll
        for (int ai = 0; ai < 2; ++ai) {
            f32x4 b[4][2][2]; u32x2 bw[4][2][2];
#pragma unroll
            for (int m = 0; m < 4; ++m) { const int row = row0 + ai * HALF + m * 16;
#pragma unroll
                for (int bj = 0; bj < 2; ++bj)
#pragma unroll
                    for (int n = 0; n < 2; ++n) {
                        if (BASE_BF16) bw[m][bj][n] = *(const u32x2*)((const bf16_t*)base + tofs(row, col0 + bj * HALF + n * 16, ldc));
                        else b[m][bj][n] = *(const f32x4*)((const float*)base + (size_t)row * ldc + col0 + bj * HALF + n * 16); } }
#pragma unroll
            for (int m = 0; m < 4; ++m) { const int row = row0 + ai * HALF + m * 16; const size_t off = (size_t)row * ldc + col0; float ss = 0.f;
#pragma unroll
                for (int bj = 0; bj < 2; ++bj)
#pragma unroll
                    for (int n = 0; n < 2; ++n) { const size_t tof = tofs(row, col0 + bj * HALF + n * 16, ldc);
                        if (BASE_BF16) { const u32x2 w = bw[m][bj][n]; b[m][bj][n] = (f32x4){__uint_as_float(w.x << 16), __uint_as_float(w.x & 0xffff0000u), __uint_as_float(w.y << 16), __uint_as_float(w.y & 0xffff0000u)}; }
                        const f32x4 v = b[m][bj][n] + acc[ai][bj][m][n] * scale;
                        if (out) *(f32x4*)(out + off + bj * HALF + n * 16) = v;
                        ss += (v[0] * v[0] + v[1] * v[1]) + (v[2] * v[2] + v[3] * v[3]);
                        if (xb) { u32x2 w; w.x = cvt_pk_bf16(v[0], v[1]); w.y = cvt_pk_bf16(v[2], v[3]); *(u32x2*)(xb + tof) = w; } }
                ss += __shfl_xor(ss, 16); ss += __shfl_xor(ss, 32);
                if (fq == 0) part[(size_t)row * 64 + u.pn * 4 + wc] = ss; }
        }
    }
};
struct EpiInProj {
    static constexpr bool PERM = true, AFTER_DRAIN = false;
    bf16_t* P; int ldp; const float* rstd; const float* ropec; const float* ropes;
    bf16_t* RQKV; bf16_t* AQKV;
    __device__ __forceinline__ void operator()(const f32x4 (&acc)[2][2][4][2], const Unit& u, int wr, int wc, int fr, int fq) const {
        const int row0 = u.pm * BM + wr * 64 + fr, d0 = wc * 32 + 8 * fq, col0 = u.pn * BM + d0; const int pn = u.pn;
        float rs[2][4];
#pragma unroll
        for (int ai = 0; ai < 2; ++ai)
#pragma unroll
            for (int m = 0; m < 4; ++m) rs[ai][m] = rstd[row0 + ai * HALF + m * 16];
        const unsigned char* dA; unsigned dBo; int pitch, hb;
        if (pn < 24) { const int seg = pn >> 3, h = pn & 7; pitch = 256; hb = 7 * 2048; dA = (const unsigned char*)(RQKV + (size_t)seg * (8192u * 2048u) + (size_t)h * 2048 * 256); dBo = 256u; }
        else if (pn >= 32 && pn < 50) { const int seg = (pn - 32) / 6, j = (pn - 32) % 6; pitch = 128; hb = 11 * 2048; dA = (const unsigned char*)(AQKV + (size_t)seg * (8192u * 1536u) + (size_t)(2 * j) * 2048 * 128); dBo = 2048u * 128u * 2u; }
        else { pitch = ldp; hb = 0; dA = (const unsigned char*)(P + u.pn * BM); dBo = 256u; }
#pragma unroll
        for (int ai = 0; ai < 2; ++ai)
#pragma unroll
            for (int mp = 0; mp < 2; ++mp) {
                f32x4 cs[2][4];
                if (pn < 16) {
#pragma unroll
                    for (int mm = 0; mm < 2; ++mm) { const int pos = (row0 + ai * HALF + (2 * mp + mm) * 16) & 2047; const float* cp = ropec + pos * 128 + d0; const float* sp = ropes + pos * 128 + d0;
                        cs[mm][0] = *(const f32x4*)cp; cs[mm][1] = *(const f32x4*)(cp + 4); cs[mm][2] = *(const f32x4*)sp; cs[mm][3] = *(const f32x4*)(sp + 4); } }
#pragma unroll
                for (int mm = 0; mm < 2; ++mm) { const int m = 2 * mp + mm; const int row = row0 + ai * HALF + m * 16; const float r = rs[ai][m];
                    f32x4 a0 = acc[ai][0][m][0] * r, a1 = acc[ai][0][m][1] * r, b0 = acc[ai][1][m][0] * r, b1 = acc[ai][1][m][1] * r;
                    if (pn < 16) { const f32x4 c0 = cs[mm][0], c1 = cs[mm][1], s0 = cs[mm][2], s1 = cs[mm][3];
                        const float sc = pn < 8 ? 1.0f : 0.0625f;
                        const f32x4 x0 = (a0 * c0 - b0 * s0) * sc, x1 = (a1 * c1 - b1 * s1) * sc, y0 = (b0 * c0 + a0 * s0) * sc, y1 = (b1 * c1 + a1 * s1) * sc;
                        a0 = x0; a1 = x1; b0 = y0; b1 = y1; }
                    else if (pn < 24) { }
                    else if (pn < 32) { a0 = a0 * sigm4(a0); a1 = a1 * sigm4(a1); b0 = b0 * sigm4(b0); b1 = b1 * sigm4(b1); }
                    else if (pn < 38) { const float sc = 0.12751743082459868f; a0 = a0 * sc; a1 = a1 * sc; b0 = b0 * sc; b1 = b1 * sc; }
                    else if (pn < 50) { }
                    else { a0 = sigm4(a0); a1 = sigm4(a1); b0 = sigm4(b0); b1 = sigm4(b1); }
                    const unsigned ro = (unsigned)((row + (row >> 11) * hb) * pitch + d0) * 2u;
                    *(u32x4*)(dA + ro) = pack8(a0, a1); *(u32x4*)(dA + ro + dBo) = pack8(b0, b1); }
            }
    }
};
struct EpiGateB {
    static constexpr bool PERM = true, AFTER_DRAIN = false;
    const bf16_t* G; int ldg; bf16_t* T; int ldt;
    __device__ __forceinline__ void operator()(const f32x4 (&acc)[2][2][4][2], const Unit& u, int wr, int wc, int fr, int fq) const {
        const int row0 = u.pm * BM + wr * 64 + fr, col0 = u.pn * BM + wc * 32 + 8 * fq;
        u32x4 gw[2][4][2];
#pragma unroll
        for (int ai = 0; ai < 2; ++ai)
#pragma unroll
            for (int m = 0; m < 4; ++m)
#pragma unroll
                for (int bj = 0; bj < 2; ++bj) gw[ai][m][bj] = *(const u32x4*)(G + (size_t)(row0 + ai * HALF + m * 16) * ldg + col0 + bj * HALF);
#pragma unroll
        for (int ai = 0; ai < 2; ++ai)
#pragma unroll
            for (int m = 0; m < 4; ++m) { const int row = row0 + ai * HALF + m * 16;
#pragma unroll
                for (int bj = 0; bj < 2; ++bj)
                    *(u32x4*)(T + (size_t)row * ldt + col0 + bj * HALF) = pack8(bfx4_lo(gw[ai][m][bj]) * acc[ai][bj][m][0], bfx4_hi(gw[ai][m][bj]) * acc[ai][bj][m][1]); }
    }
};
struct EpiGateA {
    static constexpr bool PERM = true, AFTER_DRAIN = false;
    const bf16_t* G; int ldg; const bf16_t* T; int ldt; bf16_t* O; int ldo;
    __device__ __forceinline__ void operator()(const f32x4 (&acc)[2][2][4][2], const Unit& u, int wr, int wc, int fr, int fq) const {
        const int row0 = u.pm * BM + wr * 64 + fr, col0 = u.pn * BM + wc * 32 + 8 * fq;
#pragma unroll
        for (int ai = 0; ai < 2; ++ai) {
            u32x4 gw[4][2], tw[4][2];
#pragma unroll
            for (int m = 0; m < 4; ++m)
#pragma unroll
                for (int bj = 0; bj < 2; ++bj) { const int row = row0 + ai * HALF + m * 16; gw[m][bj] = *(const u32x4*)(G + (size_t)row * ldg + col0 + bj * HALF); tw[m][bj] = *(const u32x4*)(T + (size_t)row * ldt + col0 + bj * HALF); }
#pragma unroll
            for (int m = 0; m < 4; ++m) { const int row = row0 + ai * HALF + m * 16;
#pragma unroll
                for (int bj = 0; bj < 2; ++bj)
                    *(u32x4*)(O + tofs(row, col0 + bj * HALF, ldo)) = pack8(bfx4_lo(gw[m][bj]) * acc[ai][bj][m][0] + bfx4_lo(tw[m][bj]), bfx4_hi(gw[m][bj]) * acc[ai][bj][m][1] + bfx4_hi(tw[m][bj])); }
        }
    }
};
struct EpiNull {
    static constexpr bool PERM = true, AFTER_DRAIN = false;
    float* sink;
    __device__ __forceinline__ void operator()(const f32x4 (&acc)[2][2][4][2], const Unit& u, int wr, int wc, int fr, int fq) const {
        f32x4 s = (f32x4){0.f, 0.f, 0.f, 0.f};
#pragma unroll
        for (int ai = 0; ai < 2; ++ai)
#pragma unroll
            for (int bj = 0; bj < 2; ++bj)
#pragma unroll
                for (int m = 0; m < 4; ++m)
#pragma unroll
                    for (int n = 0; n < 2; ++n) s += acc[ai][bj][m][n];
        if ((s[0] + s[1]) + (s[2] + s[3]) == 12345.678f) sink[u.pm * 16 + u.pn] = s[0];
    }
};

struct SameUnitOrder {
    __device__ bool next(int i, Unit& u) const { if (i >= 11) return false; u.pm = 0; u.pn = 0; return true; }
    __device__ __forceinline__ void a_ready(const Unit&) const {}
    __device__ __forceinline__ void done(const Unit&) const {}
};
struct PanelOrder {
    StaticOrder so; bool fast; int c;
    __host__ __device__ void init(int M, int N, int G_, int c_) { so.init(M, N, G_, c_); c = c_; fast = (G_ == 256 && so.nM == 32 && so.nN == 16); }
    __host__ __device__ bool next(int i, Unit& u) const {
        if (!fast) return so.next(i, u);
        if (i >= 2) return false;
        const int x = c & 7, j = c >> 3; u.pm = 16 * i + 4 * (x >> 1) + (j & 3); u.pn = 8 * (x & 1) + (j >> 2); return true;
    }
    __device__ __forceinline__ void a_ready(const Unit&) const {}
    __device__ __forceinline__ void done(const Unit&) const {}
};
template <class Epi, class Sched, bool ALIGN_EPI = false, bool SP2 = false>
__device__ __forceinline__ void gemm_phase(PG8_LAS unsigned char* lds, const Gemm g, const Sched& S, const Epi& E) {
    const int tid = threadIdx.x, wid = __builtin_amdgcn_readfirstlane(tid >> 6), lane = tid & 63, wr = wid >> 2, wc = wid & 3, fr = lane & 15, fq = lane >> 4;
    const int K = g.K, nt = K / BK;
    unsigned voffA[2], voffB[2];
#pragma unroll
    for (int i = 0; i < 2; ++i) { int R, C; stage_rc(tid * 16 + i * 8192, R, C); const int Rb = Epi::PERM ? ((R & ~31) + perm32(R & 31)) : R;
        voffA[i] = (unsigned)(R * BK + C) * 2u; voffB[i] = (unsigned)(Rb * BK + C) * 2u; }
    const size_t kstep = (size_t)(BM * BK * 2);
    const size_t hstep = (size_t)HALF * BK * 2;
    const size_t tstep = (size_t)BM * K * 2;
    const unsigned ldsw = (unsigned)wid * 1024u;
    const int aoff = lds_byte(wr * 64 + fr, fq * 8), boff = lds_byte(wc * 32 + fr, fq * 8);
#define PG8_SA(b, h) (((b) * 2 + (h)) * HTB)
#define PG8_SB(b, h) ((4 + (b) * 2 + (h)) * HTB)
#define PG8_STAGE(bufoff, gbase, voff) do { _Pragma("unroll") for (int _i = 0; _i < 2; ++_i) \
        __builtin_amdgcn_global_load_lds((const unsigned*)((const char*)(gbase) + (voff)[_i]), (PG8_LAS unsigned*)(lds + (bufoff) + ldsw + _i * 8192), 16, 0, 0); } while (0)
#define PG8_LDA(dst, b, h) do { _Pragma("unroll") for (int m = 0; m < 4; ++m) _Pragma("unroll") for (int k = 0; k < 2; ++k) dst[m][k] = *(const PG8_LAS bf16x8*)(lds + PG8_SA(b, h) + aoff + m * 2048 + k * 1024); } while (0)
#define PG8_LDB(dst, b, h) do { _Pragma("unroll") for (int n = 0; n < 2; ++n) _Pragma("unroll") for (int k = 0; k < 2; ++k) dst[n][k] = *(const PG8_LAS bf16x8*)(lds + PG8_SB(b, h) + boff + n * 2048 + k * 1024); } while (0)
#define PG8_MMA(ai, bj, At, Bt) do { __builtin_amdgcn_s_setprio(1); _Pragma("unroll") for (int m = 0; m < 4; ++m) _Pragma("unroll") for (int n = 0; n < 2; ++n) _Pragma("unroll") for (int k = 0; k < 2; ++k) \
        acc[ai][bj][m][n] = __builtin_amdgcn_mfma_f32_16x16x32_bf16(Bt[n][k], At[m][k], acc[ai][bj][m][n], 0, 0, 0); __builtin_amdgcn_s_setprio(0); } while (0)
#define PG8_WAIT_V(n) asm volatile("s_waitcnt vmcnt(" #n ")" ::: "memory")
#define PG8_WAIT_L(n) asm volatile("s_waitcnt lgkmcnt(" #n ")" ::: "memory")
#define PG8_BAR __builtin_amdgcn_s_barrier()
#define PG8_SCHED __builtin_amdgcn_sched_barrier(0)
    Unit cur, nxt; int ui = 0;
    if (!S.next(0, cur)) return;
    f32x4 acc[2][2][4][2];
#pragma unroll
    for (int a = 0; a < 2; ++a)
#pragma unroll
        for (int b = 0; b < 2; ++b)
#pragma unroll
            for (int m = 0; m < 4; ++m)
#pragma unroll
                for (int n = 0; n < 2; ++n) acc[a][b][m][n] = (f32x4){0.f, 0.f, 0.f, 0.f};
    bf16x8 At[4][2], B0[2][2], B1[2][2];
    const char* cA = (const char*)g.A + (size_t)cur.pm * tstep; const char* cB = (const char*)g.Bt + (size_t)cur.pn * tstep;
    S.a_ready(cur);
    if constexpr (SP2) {
        PG8_STAGE(PG8_SB(0, 0), cB, voffB); PG8_STAGE(PG8_SB(0, 1), cB + hstep, voffB); PG8_STAGE(PG8_SA(0, 0), cA, voffA); PG8_STAGE(PG8_SA(0, 1), cA + hstep, voffA);
        if (wr == 1) PG8_BAR;
        PG8_WAIT_V(2); PG8_BAR;
        PG8_STAGE(PG8_SB(1, 0), cB + kstep, voffB); PG8_STAGE(PG8_SA(1, 0), cA + kstep, voffA); PG8_STAGE(PG8_SB(1, 1), cB + hstep + kstep, voffB);
        PG8_WAIT_V(6); PG8_BAR;
    } else {
        PG8_STAGE(PG8_SB(0, 0), cB, voffB); PG8_STAGE(PG8_SA(0, 0), cA, voffA); PG8_STAGE(PG8_SB(0, 1), cB + hstep, voffB); PG8_STAGE(PG8_SA(0, 1), cA + hstep, voffA);
        if (wr == 1) PG8_BAR;
        PG8_WAIT_V(4); PG8_BAR;
        PG8_STAGE(PG8_SB(1, 0), cB + kstep, voffB); PG8_STAGE(PG8_SA(1, 0), cA + kstep, voffA); PG8_STAGE(PG8_SB(1, 1), cB + hstep + kstep, voffB);
        PG8_WAIT_V(6); PG8_BAR;
    }
    for (;;) {
        const bool has_next = S.next(ui + 1, nxt);
        const char* nA = has_next ? (const char*)g.A + (size_t)nxt.pm * tstep : cA; const char* nB = has_next ? (const char*)g.Bt + (size_t)nxt.pn * tstep : cB;
        for (int t = 0; t < nt; t += 2) {
            const bool last = (t == nt - 2);
            const char* a1 = cA + (size_t)(t + 1) * kstep;
            const char* a2 = last ? nA : cA + (size_t)(t + 2) * kstep; const char* b2 = last ? nB : cB + (size_t)(t + 2) * kstep;
            const char* a3 = a2 + kstep; const char* b3 = b2 + kstep;
            if (last && has_next) S.a_ready(nxt);
            if constexpr (SP2) {
            PG8_LDB(B0, 0, 0); PG8_LDB(B1, 0, 1); PG8_SCHED; PG8_LDA(At, 0, 0); PG8_STAGE(PG8_SA(1, 1), a1 + hstep, voffA);
            PG8_WAIT_V(8); PG8_WAIT_L(0); PG8_BAR; PG8_MMA(0, 0, At, B0); PG8_MMA(0, 1, At, B1); PG8_BAR; PG8_SCHED;
            PG8_LDA(At, 0, 1); PG8_STAGE(PG8_SB(0, 0), b2, voffB); PG8_STAGE(PG8_SB(0, 1), b2 + hstep, voffB); PG8_STAGE(PG8_SA(0, 0), a2, voffA);
            PG8_WAIT_V(8); PG8_WAIT_L(0); PG8_BAR; PG8_MMA(1, 0, At, B0); PG8_MMA(1, 1, At, B1); PG8_BAR; PG8_SCHED;
            PG8_LDB(B0, 1, 0); PG8_LDB(B1, 1, 1); PG8_SCHED; PG8_LDA(At, 1, 0); PG8_STAGE(PG8_SA(0, 1), a2 + hstep, voffA);
            PG8_WAIT_V(8); PG8_WAIT_L(0); PG8_BAR; PG8_MMA(0, 0, At, B0); PG8_MMA(0, 1, At, B1); PG8_BAR; PG8_SCHED;
            PG8_LDA(At, 1, 1); PG8_STAGE(PG8_SB(1, 0), b3, voffB); PG8_STAGE(PG8_SB(1, 1), b3 + hstep, voffB); PG8_STAGE(PG8_SA(1, 0), a3, voffA);
            PG8_WAIT_V(8); PG8_WAIT_L(0); PG8_BAR; PG8_MMA(1, 0, At, B0); PG8_MMA(1, 1, At, B1); PG8_BAR; PG8_SCHED;
            } else {
            PG8_LDB(B0, 0, 0); PG8_SCHED; PG8_LDA(At, 0, 0); PG8_STAGE(PG8_SA(1, 1), a1 + hstep, voffA);
            PG8_WAIT_L(8); PG8_BAR; PG8_WAIT_L(0); PG8_MMA(0, 0, At, B0); PG8_BAR; PG8_SCHED;
            PG8_LDB(B1, 0, 1); PG8_STAGE(PG8_SB(0, 0), b2, voffB);
            PG8_BAR; PG8_WAIT_L(0); PG8_MMA(0, 1, At, B1); PG8_BAR;
            PG8_LDA(At, 0, 1); PG8_STAGE(PG8_SA(0, 0), a2, voffA);
            PG8_BAR; PG8_WAIT_L(0); PG8_MMA(1, 0, At, B0); PG8_BAR; PG8_SCHED;
            PG8_STAGE(PG8_SB(0, 1), b2 + hstep, voffB);
            PG8_WAIT_V(6); PG8_BAR; PG8_MMA(1, 1, At, B1); PG8_BAR;
            PG8_LDB(B0, 1, 0); PG8_SCHED; PG8_LDA(At, 1, 0); PG8_STAGE(PG8_SA(0, 1), a2 + hstep, voffA);
            PG8_WAIT_L(8); PG8_BAR; PG8_WAIT_L(0); PG8_MMA(0, 0, At, B0); PG8_BAR; PG8_SCHED;
            PG8_LDB(B1, 1, 1); PG8_STAGE(PG8_SB(1, 0), b3, voffB);
            PG8_BAR; PG8_WAIT_L(0); PG8_MMA(0, 1, At, B1); PG8_BAR;
            PG8_LDA(At, 1, 1); PG8_STAGE(PG8_SA(1, 0), a3, voffA);
            PG8_BAR; PG8_WAIT_L(0); PG8_MMA(1, 0, At, B0); PG8_BAR; PG8_SCHED;
            PG8_STAGE(PG8_SB(1, 1), b3 + hstep, voffB);
            PG8_WAIT_V(6); PG8_BAR; PG8_MMA(1, 1, At, B1); PG8_BAR;
            }
        }
        if constexpr (ALIGN_EPI) { if (wr == 0) PG8_BAR; }
        if constexpr (!Epi::AFTER_DRAIN) { E(acc, cur, wr, wc, fr, fq); S.done(cur); }
        if (!has_next) break;
#pragma unroll
        for (int a = 0; a < 2; ++a)
#pragma unroll
            for (int b = 0; b < 2; ++b)
#pragma unroll
                for (int m = 0; m < 4; ++m)
#pragma unroll
                    for (int n = 0; n < 2; ++n) acc[a][b][m][n] = (f32x4){0.f, 0.f, 0.f, 0.f};
        cur = nxt; cA = nA; cB = nB; ++ui;
        if constexpr (ALIGN_EPI) { if (wr == 1) PG8_BAR; }
    }
    PG8_WAIT_V(0);
    if constexpr (!ALIGN_EPI) { if (wr == 0) PG8_BAR; }
    PG8_BAR;
    if constexpr (Epi::AFTER_DRAIN) { E.fused(acc, cur, wr, wc, fr, fq, lds, wid, lane); S.done(cur); }
#undef PG8_SA
#undef PG8_SB
#undef PG8_STAGE
#undef PG8_LDA
#undef PG8_LDB
#undef PG8_MMA
#undef PG8_WAIT_V
#undef PG8_WAIT_L
#undef PG8_BAR
#undef PG8_SCHED
}
}
constexpr int NWAVES = 8;
#ifndef MK_PER_PHASE
#define MK_PER_PHASE 0
#endif
#ifndef MK_NAIVE_MIX
#define MK_NAIVE_MIX 0
#endif
#ifndef MK_REPEAT_PHASE
#define MK_REPEAT_PHASE -1
#endif
#ifndef MK_NULL_PROBE
#define MK_NULL_PROBE 0
#endif
#ifndef MK_VAR
#define MK_VAR 0
#endif
#ifndef MK_WIN_LATE
#define MK_WIN_LATE 1
#endif
constexpr int N_PHASES = 13;

constexpr int BATCH = 4, SEQ = 2048, DM = 4096, M = BATCH * SEQ, DFF = 11008, NGU = 2 * DFF;
constexpr int RW = 2048, RH = 8, RD = 256, AW = 1536, AHT = 12, AD = 128, AOW = 512, NIN = 20992;
constexpr int C_QR = 0, C_KR = 2048, C_VR = 4096, C_GR = 6144, C_QA = 8192, C_KA = 9728, C_VA = 11264, C_UA = 12800, C_UB = 16896;
constexpr float EPS = 1e-6f;

constexpr size_t MiB = 1u << 20;
constexpr size_t WS_CTL = 0, CTL_ZERO_BYTES = 1 * MiB;
constexpr size_t WS_ROPEC = 2 * MiB, WS_ROPES = 3 * MiB;
constexpr size_t WS_RSTD = 4 * MiB;
constexpr size_t WS_PART = 5 * MiB;
constexpr size_t WS_LSE = 7 * MiB;
constexpr size_t WS_WGU1 = 8 * MiB, WS_WD1 = WS_WGU1 + 172 * MiB, WS_WIN = WS_WD1 + 86 * MiB, WS_WOA = WS_WIN + 164 * MiB, WS_WOB = WS_WOA + 16 * MiB,
                 WS_WO = WS_WOB + 4 * MiB, WS_WGU2 = WS_WO + 32 * MiB, WS_WD2 = WS_WGU2 + 172 * MiB;
constexpr size_t WS_XB = WS_WD2 + 86 * MiB;
constexpr size_t WS_P = WS_XB + 64 * MiB;
constexpr size_t WS_H = WS_P;
constexpr size_t WS_YR = WS_P + 328 * MiB;
constexpr size_t WS_OB = WS_YR + 32 * MiB;
constexpr size_t WS_YB = WS_OB + 24 * MiB;
constexpr size_t WS_T = WS_YB + 8 * MiB;
constexpr size_t WS_MG = WS_T + 128 * MiB;
constexpr size_t WS_RQKV = WS_MG + 64 * MiB;
constexpr size_t WS_AQKV = WS_RQKV + 96 * MiB;
constexpr size_t WS_END = WS_AQKV + 72 * MiB;
static_assert((size_t)NGU * DM * 2 == 172 * MiB && (size_t)DM * DFF * 2 == 86 * MiB && (size_t)NIN * DM * 2 == 164 * MiB && (size_t)M * NIN * 2 == 328 * MiB && (size_t)M * DFF * 2 == 172 * MiB, "d_ws map");
constexpr int CW_TMO = 0, CW_CODE = 1;
constexpr int CW_BAR = 4096;

constexpr int RING_OFF = 0, RING_BYTES = 131072;
constexpr int LDSCTL_OFF = 139264, MISC_OFF = LDSCTL_OFF + 320;
constexpr int LDS_BYTES = 147456;
static_assert(MISC_OFF + 128 <= LDS_BYTES, "LDS map");

#define GAS __attribute__((address_space(1)))
#define LAS __attribute__((address_space(3)))
typedef unsigned short bf16;
typedef unsigned v4u __attribute__((ext_vector_type(4)));
typedef unsigned v2u __attribute__((ext_vector_type(2)));
typedef float f32x4 __attribute__((ext_vector_type(4)));
typedef short bf16x8 __attribute__((ext_vector_type(8)));
typedef GAS unsigned gu32;
typedef GAS unsigned long long gu64;
#define RLX_AGENT __ATOMIC_RELAXED, __HIP_MEMORY_SCOPE_AGENT
#define LDS_WAIT() asm volatile("s_waitcnt lgkmcnt(0)" ::: "memory")
#define VM_WAIT() asm volatile("s_waitcnt vmcnt(0)" ::: "memory")
__device__ __forceinline__ unsigned f2bf(float f) { unsigned u = __builtin_bit_cast(unsigned, f); return (u + 0x7fffu + ((u >> 16) & 1u)) >> 16; }
__device__ __forceinline__ unsigned pk2(float lo, float hi) { return f2bf(lo) | (f2bf(hi) << 16); }
__device__ __forceinline__ float bf2f(bf16 h) { return __uint_as_float((unsigned)h << 16); }
__device__ __forceinline__ float bflo(unsigned w) { return __uint_as_float(w << 16); }
__device__ __forceinline__ float bfhi(unsigned w) { return __uint_as_float(w & 0xffff0000u); }

#define XB_TMO      128
#define XB_XCNT(j)  (256  + 64 * (j))
#define XB_XSUB(j)  (1280 + 64 * (j))
#define XB_XGEN(j)  (2304 + 64 * (j))
#define XB_TOP      3328
#define XB_TOPGEN   3392
#define XCD_BAR_WORDS 3456
#define XB_SPIN_CAP (1u << 18)

__device__ __forceinline__ unsigned xb_ld(unsigned* p)              { return __hip_atomic_load(p, __ATOMIC_RELAXED, __HIP_MEMORY_SCOPE_AGENT); }
__device__ __forceinline__ unsigned xb_add(unsigned* p, unsigned v) { return __hip_atomic_fetch_add(p, v, __ATOMIC_RELAXED, __HIP_MEMORY_SCOPE_AGENT); }
__device__ __forceinline__ unsigned xb_xcc_id() { return (unsigned)__builtin_amdgcn_s_getreg((3 << 11) | 20) & 0xFu; }
#define XB_SPIN(cond, bar) do { unsigned _sp = 0; while (cond) { __builtin_amdgcn_s_sleep(1); \
    if ((++_sp & 255u) == 0u) { if (xb_ld(&(bar)[XB_TMO])) break; if (_sp > XB_SPIN_CAP) { atomicAdd(&(bar)[XB_TMO], 1u); break; } } } } while (0)

struct XcdBarrier {
    unsigned* bar; unsigned x;
    volatile LAS unsigned* st;
};

__device__ __forceinline__ XcdBarrier xcd_barrier_post(unsigned* bar, volatile LAS unsigned* st) {
    XcdBarrier b; b.bar = bar; b.x = xb_xcc_id(); b.st = st;
    if (threadIdx.x == 0) (void)xb_add(&bar[XB_XCNT(b.x)], 1u);
    return b;
}
__device__ __forceinline__ void xcd_barrier_complete(unsigned* bar, unsigned x, unsigned& nloc, unsigned& nx) {
    const unsigned G = gridDim.x * gridDim.y * gridDim.z;
    unsigned sum, cnt, mine, sp = 0u;
    for (;;) {
        sum = 0u; cnt = 0u; mine = 0u;
#pragma unroll
        for (unsigned j = 0; j < 16; ++j) { const unsigned c = xb_ld(&bar[XB_XCNT(j)]); sum += c; cnt += (c > 0u) ? 1u : 0u; mine = (j == x) ? c : mine; }
        if (sum == G) break;
        __builtin_amdgcn_s_sleep(1);
        if ((++sp & 255u) == 0u) { if (xb_ld(&bar[XB_TMO])) break; if (sp > XB_SPIN_CAP) { atomicAdd(&bar[XB_TMO], 1u); break; } }
    }
    nloc = mine > 0u ? mine : 1u; nx = cnt > 0u ? cnt : 1u;
}

__device__ __forceinline__ void xcd_barrier(const XcdBarrier& b) {
    asm volatile("s_waitcnt vmcnt(0)" ::: "memory");
    __syncthreads();
    if (threadIdx.x == 0) {
        unsigned* bar = b.bar;
        __builtin_amdgcn_s_waitcnt(0);
        unsigned nloc = b.st[0], nx = b.st[1];
        if (nloc == 0u) { xcd_barrier_complete(bar, b.x, nloc, nx); b.st[0] = nloc; b.st[1] = nx; }
        const unsigned old = xb_add(&bar[XB_XSUB(b.x)], 1u);
        const unsigned gen = old / nloc;
        if (old + 1u == (gen + 1u) * nloc) {
            __builtin_amdgcn_fence(__ATOMIC_RELEASE, "agent");
            asm volatile("s_waitcnt vmcnt(0)" ::: "memory");
            const unsigned og = xb_add(&bar[XB_TOP], 1u);
            const unsigned tg = og / nx;
            if (og + 1u == (tg + 1u) * nx) xb_add(&bar[XB_TOPGEN], 1u);
            else XB_SPIN(xb_ld(&bar[XB_TOPGEN]) == tg, bar);
            __builtin_amdgcn_fence(__ATOMIC_ACQUIRE, "agent");
            xb_add(&bar[XB_XGEN(b.x)], 1u);
            asm volatile("s_waitcnt vmcnt(0)" ::: "memory");
        } else {
            XB_SPIN(xb_ld(&bar[XB_XGEN(b.x)]) == gen, bar);
            __builtin_amdgcn_fence(__ATOMIC_ACQUIRE, "agent");
            asm volatile("s_waitcnt vmcnt(0)" ::: "memory");
        }
    }
    __syncthreads();
}
struct Frame {
    LAS unsigned char* lds;
    volatile LAS unsigned* MISC;
    gu32* ctl;
    int tid, lane, wave;
    int vcu, G;
};
__device__ __forceinline__ float wave_sum(float v) {
#pragma unroll
    for (int o = 1; o < 64; o <<= 1) v += __shfl_xor(v, o);
    return v;
}
__device__ __forceinline__ float wave_max(float v) {
#pragma unroll
    for (int o = 1; o < 64; o <<= 1) v = fmaxf(v, __shfl_xor(v, o));
    return v;
}

__device__ __forceinline__ void conv_item(const float* W, int K, int N, const float* gain, bf16* WT, int drow0, int k0, int n0, LAS float* scr, int lane) {
    const int kr = lane >> 4, c4 = lane & 15;
    f32x4 v[16];
#pragma unroll
    for (int i = 0; i < 16; ++i) v[i] = __builtin_nontemporal_load((const GAS f32x4*)(W + (size_t)(k0 + 4 * i + kr) * N + n0 + 4 * c4));
#pragma unroll
    for (int i = 0; i < 16; ++i) { const int k = 4 * i + kr; *(LAS f32x4*)(scr + k * 64 + ((4 * c4) ^ (((k >> 3) & 7) << 2))) = v[i]; }
    LDS_WAIT(); asm volatile("" ::: "memory");
    const int c = lane & 7;
    f32x4 g0 = (f32x4){1.f, 1.f, 1.f, 1.f}, g1 = g0;
    if (gain) { g0 = *(const GAS f32x4*)(gain + k0 + 8 * c); g1 = *(const GAS f32x4*)(gain + k0 + 8 * c + 4); }
#pragma unroll
    for (int j = 0; j < 8; ++j) { const int n = (lane >> 3) + 8 * j; const LAS float* s = scr + (8 * c) * 64 + (n ^ (c << 2));
        v4u o; o.x = pk2(s[0 * 64] * g0[0], s[1 * 64] * g0[1]); o.y = pk2(s[2 * 64] * g0[2], s[3 * 64] * g0[3]); o.z = pk2(s[4 * 64] * g1[0], s[5 * 64] * g1[1]); o.w = pk2(s[6 * 64] * g1[2], s[7 * 64] * g1[3]);
        *(GAS v4u*)(WT + pg8::tofs(drow0 + n, k0 + 8 * c, K)) = o; }
    LDS_WAIT(); asm volatile("" ::: "memory");
}
template <int MODE> __device__ __forceinline__ void conv_matrix(Frame& F, const float* W, int K, int N, const float* gain, bf16* WT, int& base, int wk, int NW) {
    LAS float* scr = (LAS float*)(F.lds + RING_OFF + F.wave * 16384);
    const int nblk = N / 64, nitems = (K / 64) * nblk;
    int it = wk - (base % NW); if (it < 0) it += NW;
    for (; it < nitems; it += NW) { const int kb = it / nblk, nb = it % nblk, n0 = nb * 64;
        const int drow0 = MODE == 0 ? n0 : (256 * (n0 >> 7) + (n0 & 127) + (MODE == 2 ? 128 : 0));
        conv_item(W, K, N, gain, WT, drow0, kb * 64, n0, scr, F.lane); }
    base += nitems;
}
__device__ __forceinline__ void row_to_bf16_rstd(const float* xrow, bf16* XBt, int m, float* rstd_out, int lane) {
    const GAS f32x4* xr = (const GAS f32x4*)xrow + lane;
    f32x4 v[16]; float s = 0.f;
#pragma unroll
    for (int j = 0; j < 16; ++j) { v[j] = xr[64 * j]; s += (v[j].x * v[j].x + v[j].y * v[j].y) + (v[j].z * v[j].z + v[j].w * v[j].w); }
    const float tot = wave_sum(s);
#pragma unroll
    for (int j = 0; j < 16; ++j) { v2u w; w.x = pk2(v[j].x, v[j].y); w.y = pk2(v[j].z, v[j].w); *(GAS v2u*)(XBt + pg8::tofs(m, 256 * j + 4 * lane, DM)) = w; }
    if (lane == 0) *rstd_out = 1.0f / sqrtf(tot * (1.0f / DM) + EPS);
}
struct Ptrs {
    const float* in[15]; float* out; unsigned char* ws;
};
__device__ __forceinline__ void p0_prologue(Frame& F, const Ptrs& A) {
    unsigned char* ws = A.ws;
    int base = 0; const int wk0 = F.vcu * NWAVES + F.wave, NW0 = F.G * NWAVES;
    conv_matrix<1>(F, A.in[2], DM, DFF, A.in[1], (bf16*)(ws + WS_WGU1), base, wk0, NW0);
    conv_matrix<2>(F, A.in[3], DM, DFF, A.in[1], (bf16*)(ws + WS_WGU1), base, wk0, NW0);
#if !MK_WIN_LATE
    conv_matrix<0>(F, A.in[6], DM, NIN, A.in[5], (bf16*)(ws + WS_WIN), base, wk0, NW0);
#endif
    const int gw = F.vcu * NWAVES + F.wave, NGW = F.G * NWAVES;
    for (int m = gw; m < M; m += NGW) row_to_bf16_rstd(A.in[0] + (size_t)m * DM, (bf16*)(ws + WS_XB), m, (float*)(ws + WS_RSTD) + m, F.lane);
    float* rc = (float*)(ws + WS_ROPEC); float* rsn = (float*)(ws + WS_ROPES);
    for (int e = blockIdx.x * (NWAVES * 64) + F.tid; e < SEQ * 128; e += F.G * NWAVES * 64) { const int pos = e >> 7, i = e & 127;
        double p = 1.0, b = 0.930572040929699;
#pragma unroll
        for (int bit = 0; bit < 7; ++bit) { if ((i >> bit) & 1) p *= b; b *= b; }
        const float ang = (float)pos * (float)p;
        double t = (double)ang * 0.15915494309189535; t -= __builtin_rint(t);
        const float r = (float)(t * 6.283185307179586);
        rc[e] = cosf(r); rsn[e] = sinf(r); }
}
template <int JOB> __device__ __forceinline__ void tail_convert(Frame& F, const Ptrs& A, int first) {
    if ((int)blockIdx.x < first) return;
    if (JOB == 4) { int base4 = 0; conv_matrix<0>(F, A.in[6], DM, NIN, A.in[5], (bf16*)(A.ws + WS_WIN), base4, ((int)blockIdx.x - first) * NWAVES + F.wave, (F.G - first) * NWAVES); return; }
    unsigned char* ws = A.ws; int base = 0; const int wk = ((int)blockIdx.x - first) * NWAVES + F.wave, NW = (F.G - first) * NWAVES;
    if (JOB == 1) conv_matrix<0>(F, A.in[4], DFF, DM, nullptr, (bf16*)(ws + WS_WD1), base, wk, NW);
    if (JOB == 2) { conv_matrix<0>(F, A.in[7], RW, DM, nullptr, (bf16*)(ws + WS_WOA), base, wk, NW);
        conv_matrix<0>(F, A.in[8], AOW, DM, nullptr, (bf16*)(ws + WS_WOB), base, wk, NW);
        conv_matrix<0>(F, A.in[9], DM, DM, nullptr, (bf16*)(ws + WS_WO), base, wk, NW);
        conv_matrix<1>(F, A.in[11], DM, DFF, A.in[10], (bf16*)(ws + WS_WGU2), base, wk, NW);
        conv_matrix<2>(F, A.in[12], DM, DFF, A.in[10], (bf16*)(ws + WS_WGU2), base, wk, NW); }
    if (JOB == 3) conv_matrix<0>(F, A.in[13], DFF, DM, nullptr, (bf16*)(ws + WS_WD2), base, wk, NW);
}
__device__ __forceinline__ void reduce_rstd(Frame& F, const float* part, float* rstd) {
    const int gw = F.vcu * NWAVES + F.wave, NGW = F.G * NWAVES;
    for (int m = gw; m < M; m += NGW) { const float tot = wave_sum(part[(size_t)m * 64 + F.lane]); if (F.lane == 0) rstd[m] = 1.0f / sqrtf(tot * (1.0f / DM) + EPS); }
}
__device__ __forceinline__ void final_norm(Frame& F, float* out, const float* part, const float* gain) {
    const int gw = F.vcu * NWAVES + F.wave, NGW = F.G * NWAVES;
    for (int m = gw; m < M; m += NGW) { const float tot = wave_sum(part[(size_t)m * 64 + F.lane]); const float rs = 1.0f / sqrtf(tot * (1.0f / DM) + EPS);
        GAS f32x4* xr = (GAS f32x4*)(out + (size_t)m * DM) + F.lane; const GAS f32x4* gr = (const GAS f32x4*)gain + F.lane;
        f32x4 v[16];
#pragma unroll
        for (int j = 0; j < 16; ++j) v[j] = xr[64 * j];
#pragma unroll
        for (int j = 0; j < 16; ++j) xr[64 * j] = v[j] * rs * gr[64 * j]; }
}

__device__ __forceinline__ void naive_attn(Frame& F, const bf16* P, bf16* YB) {
    LAS float* qf = (LAS float*)(F.lds);
    LAS float* sc = qf + 384;
    LAS float* red = sc + 400;
    const int t = F.tid;
    for (int uidx = blockIdx.x; uidx < M * 4; uidx += F.G) {
        const int row = uidx >> 2, hi = uidx & 3, b = row >> 11, s = row & 2047;
        if (t < 384) { const int g = t >> 7, d = t & 127; qf[t] = bf2f(P[(size_t)row * NIN + C_QA + (4 * g + hi) * 128 + d]); }
        __syncthreads();
        if (t < 387) { const int g = t / 129, kk = t % 129, r = g == 0 ? 1 : (g == 1 ? 4 : 16), pos = s - kk * r; float a = -1e30f;
            if (pos >= 0) { const bf16* kp = P + (size_t)(b * SEQ + pos) * NIN + C_KA + (4 * g + hi) * 128; a = 0.f;
                for (int d = 0; d < 128; ++d) a += qf[g * 128 + d] * bf2f(kp[d]); }
            sc[t] = a; }
        __syncthreads();
        float mx = -1e30f; for (int k = 0; k < 387; ++k) mx = fmaxf(mx, sc[k]);
        float den = 0.f; for (int k = 0; k < 387; ++k) den += __builtin_amdgcn_exp2f(sc[k] - mx);
        { const int d = t & 127, part = t >> 7; float y = 0.f;
          for (int k = part * 97; k < (part + 1) * 97 && k < 387; ++k) { const int g = k / 129, kk = k % 129, r = g == 0 ? 1 : (g == 1 ? 4 : 16), pos = s - kk * r;
              if (pos >= 0) y += __builtin_amdgcn_exp2f(sc[k] - mx) * bf2f(P[(size_t)(b * SEQ + pos) * NIN + C_VA + (4 * g + hi) * 128 + d]); }
          red[part * 128 + d] = y; }
        __syncthreads();
        if (t < 128) { const float y = (red[t] + red[128 + t]) + (red[256 + t] + red[384 + t]); YB[pg8::tofs(row, hi * 128 + t, AOW)] = (bf16)f2bf(y / den); }
        __syncthreads();
    }
}
__device__ __forceinline__ void naive_ret(Frame& F, const bf16* P, bf16* YR) {
    LAS float* qf = (LAS float*)(F.lds);
    LAS float* sc = qf + 256;
    LAS float* red = sc + 2048;
    LAS float* wsum = red + 512;
    const int t = F.tid;
    for (int uidx = blockIdx.x; uidx < M * RH; uidx += F.G) {
        const int row = uidx >> 3, h = uidx & 7, b = row >> 11, s = row & 2047;
        const float l2g = __builtin_log2f(1.0f - __builtin_amdgcn_exp2f(-5.0f - (float)h));
        if (t < 256) qf[t] = bf2f(P[(size_t)row * NIN + C_QR + h * 256 + t]);
        __syncthreads();
        for (int j = t; j <= s; j += 512) { const bf16* kp = P + (size_t)(b * SEQ + j) * NIN + C_KR + h * 256; float a = 0.f;
            for (int d = 0; d < 256; ++d) a += qf[d] * bf2f(kp[d]);
            sc[j] = a * __builtin_amdgcn_exp2f(l2g * (float)(s - j)); }
        __syncthreads();
        { const int e = t & 255, half = t >> 8; float o = 0.f; const bf16* vp = P + (size_t)(b * SEQ) * NIN + C_VR + h * 256 + e;
          for (int j = half; j <= s; j += 2) o += sc[j] * bf2f(vp[(size_t)j * NIN]);
          red[half * 256 + e] = o; }
        __syncthreads();
        float o = 0.f, ss = 0.f;
        if (t < 256) { o = red[t] + red[256 + t]; ss = o * o; }
        ss = wave_sum(ss); if (F.lane == 0) wsum[F.wave] = ss;
        __syncthreads();
        if (t < 256) { const float tot = (wsum[0] + wsum[1]) + (wsum[2] + wsum[3]); const float rs = 1.0f / sqrtf(tot * (1.0f / 256.0f) + EPS);
            const float gt = bf2f(P[(size_t)row * NIN + C_GR + h * 256 + t]);
            YR[pg8::tofs(row, h * 256 + t, RW)] = (bf16)f2bf(gt * (o * rs)); }
        __syncthreads();
    }
}
typedef short v4i16_t __attribute__((ext_vector_type(4)));
__device__ __forceinline__ bf16x8 tr_pair(const LAS unsigned char* p0, const LAS unsigned char* p1) {
    const v4i16_t lo = __builtin_amdgcn_ds_read_tr16_b64_v4i16((LAS v4i16_t*)p0), hi = __builtin_amdgcn_ds_read_tr16_b64_v4i16((LAS v4i16_t*)p1);
    return __builtin_shufflevector(lo, hi, 0, 1, 2, 3, 4, 5, 6, 7);
}
template <int D> __device__ __forceinline__ unsigned tile_toff(size_t stride, int tid) { constexpr int PPR = D / 8; return (unsigned)((size_t)(tid / PPR) * stride * 2 + (size_t)(tid % PPR) * 16); }
template <int D> __device__ __forceinline__ void tile_load(v4u (&r)[D / 64], const bf16* base, size_t stride, unsigned toff) {
    constexpr int PPR = D / 8;
#pragma unroll
    for (int i = 0; i < D / 64; ++i) r[i] = *(const GAS v4u*)((const char*)base + (size_t)i * (512 / PPR) * stride * 2 + toff);
}
template <int D, int STR> __device__ __forceinline__ void tile_store(LAS unsigned char* buf, const v4u (&r)[D / 64], int tid) {
    constexpr int PPR = D / 8; LAS unsigned char* p0 = buf + (tid / PPR) * STR + (tid % PPR) * 16;
#pragma unroll
    for (int i = 0; i < D / 64; ++i) *(LAS v4u*)(p0 + i * (512 / PPR) * STR) = r[i];
}
template <int DK, int KSTR> __device__ __forceinline__ void st_compute(f32x4 (&st)[4], const LAS unsigned char* Kb, const bf16x8 (&qf)[DK / 32], int lane) {
    const LAS unsigned char* kp = Kb + (lane & 15) * KSTR + (lane >> 4) * 16;
    bf16x8 kf[2][4];
#pragma unroll
    for (int kg = 0; kg < 4; ++kg) { kf[0][kg] = *(const LAS bf16x8*)(kp + kg * 16 * KSTR); st[kg] = (f32x4){0.f, 0.f, 0.f, 0.f}; }
#pragma unroll
    for (int ks = 0; ks < DK / 32; ++ks) {
        if (ks + 1 < DK / 32) {
#pragma unroll
            for (int kg = 0; kg < 4; ++kg) kf[(ks + 1) & 1][kg] = *(const LAS bf16x8*)(kp + kg * 16 * KSTR + (ks + 1) * 64); }
        __builtin_amdgcn_sched_barrier(0);
#pragma unroll
        for (int kg = 0; kg < 4; ++kg) st[kg] = __builtin_amdgcn_mfma_f32_16x16x32_bf16(kf[ks & 1][kg], qf[ks], st[kg], 0, 0, 0);
        __builtin_amdgcn_sched_barrier(0);
    }
}
template <int DV, int VSTR> __device__ __forceinline__ void pv_compute(f32x4 (&of)[DV / 16], const LAS unsigned char* Vb, const f32x4 (&p)[4], int lane) {
    const LAS unsigned char* vp = Vb + (4 * (lane >> 4) + ((lane & 15) >> 2)) * VSTR + (lane & 3) * 8;
    bf16x8 pf[2];
#pragma unroll
    for (int s = 0; s < 2; ++s) { v4u w; w.x = pg8::cvt_pk_bf16(p[2 * s][0], p[2 * s][1]); w.y = pg8::cvt_pk_bf16(p[2 * s][2], p[2 * s][3]); w.z = pg8::cvt_pk_bf16(p[2 * s + 1][0], p[2 * s + 1][1]); w.w = pg8::cvt_pk_bf16(p[2 * s + 1][2], p[2 * s + 1][3]);
        pf[s] = __builtin_bit_cast(bf16x8, w); }
    constexpr int GPS = DV / 64, NB = 2 * GPS;
    bf16x8 vf[2][4];
#pragma unroll
    for (int j = 0; j < 4; ++j) { const LAS unsigned char* a0 = vp + j * 32; vf[0][j] = tr_pair(a0, a0 + 16 * VSTR); }
#pragma unroll
    for (int b = 0; b < NB; ++b) {
        if (b + 1 < NB) { const int s1 = (b + 1) / GPS, g1 = 4 * ((b + 1) % GPS);
#pragma unroll
            for (int j = 0; j < 4; ++j) { const LAS unsigned char* a0 = vp + (32 * s1) * VSTR + (g1 + j) * 32; vf[(b + 1) & 1][j] = tr_pair(a0, a0 + 16 * VSTR); } }
        __builtin_amdgcn_sched_barrier(0);
        const int s = b / GPS, g0 = 4 * (b % GPS);
#pragma unroll
        for (int j = 0; j < 4; ++j) of[g0 + j] = __builtin_amdgcn_mfma_f32_16x16x32_bf16(vf[b & 1][j], pf[s], of[g0 + j], 0, 0, 0);
        __builtin_amdgcn_sched_barrier(0);
    }
}
constexpr int MIX_LDS_BYTES = 2 * (64 * (2 * 256 + 16) + 64 * (2 * 256 + 32));

__device__ __forceinline__ void ret_unit(Frame& F, const bf16* RQKV, const bf16* P, bf16* YR, int b, int h, int n) {
    constexpr int KSTR = 2 * RD + 32, VSTR = 2 * RD + 32, KBUF = 64 * KSTR, BUF = KBUF + 64 * VSTR;
    const int lane = F.lane, w = F.wave, kr = lane & 15, quad = lane >> 4, tid = F.tid;
    const float l2g = __builtin_log2f(1.0f - __builtin_amdgcn_exp2f(-5.0f - (float)h));
    const size_t rowq = (size_t)b * SEQ + 128 * n + 16 * w + kr;
    const size_t hrow = (size_t)(b * RH + h) * SEQ;
    const bf16* qbase = RQKV + hrow * RD; const bf16* kbase = qbase + (size_t)M * RW; const bf16* vbase = kbase + (size_t)M * RW;
    bf16x8 qf[RD / 32];
#pragma unroll
    for (int ks = 0; ks < RD / 32; ++ks) qf[ks] = *(const GAS bf16x8*)(qbase + (size_t)(128 * n + 16 * w + kr) * RD + 32 * ks + 8 * quad);
    f32x4 of[RD / 16];
#pragma unroll
    for (int i = 0; i < RD / 16; ++i) of[i] = (f32x4){0.f, 0.f, 0.f, 0.f};
    const int nsc = 2 * (n + 1); const float qi = (float)(128 * n + 16 * w + kr);
    float cr[4], gk[4];
#pragma unroll
    for (int r = 0; r < 4; ++r) { cr[r] = __builtin_amdgcn_exp2f(-l2g * (float)(4 * quad + r)); gk[r] = __uint_as_float(__builtin_amdgcn_readfirstlane(__float_as_uint(__builtin_amdgcn_exp2f(-l2g * (float)(16 * r))))); }
    v4u rk[RD / 64], rv[RD / 64];
    const unsigned toff = tile_toff<RD>(RD, tid);
    tile_load<RD>(rk, kbase, RD, toff); tile_load<RD>(rv, vbase, RD, toff);
    tile_store<RD, KSTR>(F.lds, rk, tid); tile_store<RD, VSTR>(F.lds + KBUF, rv, tid);
    __syncthreads();
    for (int sc = 0; sc < nsc; ++sc) {
        const LAS unsigned char* Kb = F.lds + (sc & 1) * BUF; LAS unsigned char* Nb = F.lds + ((sc + 1) & 1) * BUF;
        const bool more = sc + 1 < nsc;
        if (more) { tile_load<RD>(rk, kbase + (size_t)(64 * (sc + 1)) * RD, RD, toff); tile_load<RD>(rv, vbase + (size_t)(64 * (sc + 1)) * RD, RD, toff); }
        f32x4 st[4];
        st_compute<RD, KSTR>(st, Kb, qf, lane);
        const float aq = __builtin_amdgcn_exp2f(l2g * (qi - (float)(64 * sc)));
        if (sc >= 2 * n) {
            const float d0 = qi - (float)(64 * sc + 4 * quad);
#pragma unroll
            for (int kg = 0; kg < 4; ++kg)
#pragma unroll
                for (int r = 0; r < 4; ++r) { const float d = d0 - (float)(16 * kg + r); st[kg][r] = d >= 0.f ? st[kg][r] * ((aq * gk[kg]) * cr[r]) : 0.f; }
        } else {
#pragma unroll
            for (int kg = 0; kg < 4; ++kg)
#pragma unroll
                for (int r = 0; r < 4; ++r) st[kg][r] = st[kg][r] * ((aq * gk[kg]) * cr[r]);
        }
        pv_compute<RD, VSTR>(of, Kb + KBUF, st, lane);
        if (more) { tile_store<RD, KSTR>(Nb, rk, tid); tile_store<RD, VSTR>(Nb + KBUF, rv, tid); }
        __syncthreads();
    }
    float ss = 0.f;
#pragma unroll
    for (int i = 0; i < RD / 16; ++i) ss += (of[i][0] * of[i][0] + of[i][1] * of[i][1]) + (of[i][2] * of[i][2] + of[i][3] * of[i][3]);
    ss += __shfl_xor(ss, 16); ss += __shfl_xor(ss, 32);
    const float rs = 1.0f / sqrtf(ss * (1.0f / RD) + EPS);
    const bf16* gp = P + rowq * NIN + C_GR + h * RD + 4 * quad;
#pragma unroll
    for (int i = 0; i < RD / 16; ++i) { const v2u gw = *(const GAS v2u*)(gp + 16 * i);
        v2u o; o.x = pg8::cvt_pk_bf16(bflo(gw.x) * (of[i][0] * rs), bfhi(gw.x) * (of[i][1] * rs)); o.y = pg8::cvt_pk_bf16(bflo(gw.y) * (of[i][2] * rs), bfhi(gw.y) * (of[i][3] * rs));
        *(GAS v2u*)(YR + pg8::tofs((int)rowq, h * RD + 4 * quad + 16 * i, RW)) = o; }
}
__device__ __forceinline__ void ret_phase(Frame& F, const bf16* RQKV, const bf16* P, bf16* YR) {
    for (int up = F.vcu; up < BATCH * RH * 8; up += F.G) { const int np = up & 7, h = (up >> 3) & 7, b = up >> 6;
        ret_unit(F, RQKV, P, YR, b, h, 15 - np); ret_unit(F, RQKV, P, YR, b, h, np); }
}
__device__ __forceinline__ void attn_unit(Frame& F, const bf16* AQKV, bf16* OB, float* LSE, int b, int g, int hi, int c, int n) {
    constexpr int KSTR = 2 * AD + 32, VSTR = 2 * AD + 32, KBUF = 64 * KSTR, BUF = KBUF + 64 * VSTR;
    const int lane = F.lane, w = F.wave, kr = lane & 15, quad = lane >> 4, tid = F.tid;
    const int r = g == 0 ? 1 : (g == 1 ? 4 : 16), hd = 4 * g + hi;
    const int uq = 128 * n + 16 * w + kr;
    const size_t rowq = (size_t)b * SEQ + (size_t)uq * r + c;
    const int ub0 = n > 0 ? 128 * (n - 1) : 0;
    const size_t kstride = (size_t)r * AD; const size_t hrow = (size_t)(b * AHT + hd) * SEQ;
    const bf16* kbase = AQKV + (size_t)M * AW + (hrow + (size_t)ub0 * r + c) * AD; const bf16* vbase = kbase + (size_t)M * AW;
    bf16x8 qf[AD / 32];
#pragma unroll
    for (int ks = 0; ks < AD / 32; ++ks) qf[ks] = *(const GAS bf16x8*)(AQKV + (hrow + (size_t)uq * r + c) * AD + 32 * ks + 8 * quad);
    f32x4 of[AD / 16];
#pragma unroll
    for (int i = 0; i < AD / 16; ++i) of[i] = (f32x4){0.f, 0.f, 0.f, 0.f};
    float mrun = -1e30f, den = 0.f;
    const int nsc = n > 0 ? 4 : 2;
    v4u rk[AD / 64], rv[AD / 64];
    const unsigned toff = tile_toff<AD>(kstride, tid);
    tile_load<AD>(rk, kbase, kstride, toff); tile_load<AD>(rv, vbase, kstride, toff);
    tile_store<AD, KSTR>(F.lds, rk, tid); tile_store<AD, VSTR>(F.lds + KBUF, rv, tid);
    __syncthreads();
    for (int sc = 0; sc < nsc; ++sc) {
        const LAS unsigned char* Kb = F.lds + (sc & 1) * BUF; LAS unsigned char* Nb = F.lds + ((sc + 1) & 1) * BUF;
        const bool more = sc + 1 < nsc;
        if (more) { tile_load<AD>(rk, kbase + (size_t)(64 * (sc + 1)) * kstride, kstride, toff); tile_load<AD>(rv, vbase + (size_t)(64 * (sc + 1)) * kstride, kstride, toff); }
        f32x4 st[4];
        st_compute<AD, KSTR>(st, Kb, qf, lane);
        const int dq = uq - (ub0 + 64 * sc + 4 * quad);
        float mx = -1e30f;
#pragma unroll
        for (int kg = 0; kg < 4; ++kg)
#pragma unroll
            for (int q = 0; q < 4; ++q) { const int d = dq - (16 * kg + q); const bool ok = d >= 0 && d <= 128; st[kg][q] = ok ? st[kg][q] : -1e30f; mx = fmaxf(mx, st[kg][q]); }
        mx = fmaxf(mx, __shfl_xor(mx, 16)); mx = fmaxf(mx, __shfl_xor(mx, 32));
        const float mnew = fmaxf(mrun, mx), alpha = __builtin_amdgcn_exp2f(mrun - mnew); mrun = mnew;
        float rsum = 0.f;
#pragma unroll
        for (int kg = 0; kg < 4; ++kg)
#pragma unroll
            for (int q = 0; q < 4; ++q) { const float pv = st[kg][q] > -1e29f ? __builtin_amdgcn_exp2f(st[kg][q] - mnew) : 0.f; st[kg][q] = pv; rsum += pv; }
        rsum += __shfl_xor(rsum, 16); rsum += __shfl_xor(rsum, 32);
        den = den * alpha + rsum;
#pragma unroll
        for (int i = 0; i < AD / 16; ++i) of[i] = of[i] * alpha;
        pv_compute<AD, VSTR>(of, Kb + KBUF, st, lane);
        if (more) { tile_store<AD, KSTR>(Nb, rk, tid); tile_store<AD, VSTR>(Nb + KBUF, rv, tid); }
        __syncthreads();
    }
    const float inv = 1.0f / den;
    bf16* op = OB + rowq * AW + hd * AD + 4 * quad;
#pragma unroll
    for (int i = 0; i < AD / 16; ++i) { v2u o; o.x = pg8::cvt_pk_bf16(of[i][0] * inv, of[i][1] * inv); o.y = pg8::cvt_pk_bf16(of[i][2] * inv, of[i][3] * inv); *(GAS v2u*)(op + 16 * i) = o; }
    if (quad == 0) LSE[rowq * AHT + hd] = mrun + __builtin_log2f(den);
}
__device__ __forceinline__ void attn_phase(Frame& F, const bf16* AQKV, bf16* OB, float* LSE) {
    for (int u = F.vcu; u < 768; u += F.G) { const int g = u >> 8, v = u & 255, b = v >> 6, hi = (v >> 4) & 3, x = v & 15;
        const int c = g == 0 ? 0 : (g == 1 ? (x >> 2) : x), n = g == 0 ? x : (g == 1 ? (x & 3) : 0);
        attn_unit(F, AQKV, OB, LSE, b, g, hi, c, n); }
}
__device__ __forceinline__ void attn_merge(Frame& F, const bf16* OB, const float* LSE, bf16* YB) {
    for (int e = blockIdx.x * (NWAVES * 64) + F.tid; e < M * 4 * 16; e += F.G * NWAVES * 64) { const int row = e >> 6, hi = (e >> 4) & 3, ch = e & 15;
        const float l0 = LSE[row * AHT + hi], l1 = LSE[row * AHT + 4 + hi], l2 = LSE[row * AHT + 8 + hi], mx = fmaxf(l0, fmaxf(l1, l2));
        float w0 = __builtin_amdgcn_exp2f(l0 - mx), w1 = __builtin_amdgcn_exp2f(l1 - mx), w2 = __builtin_amdgcn_exp2f(l2 - mx); const float inv = 1.0f / (w0 + w1 + w2); w0 *= inv; w1 *= inv; w2 *= inv;
        const bf16* op = OB + (size_t)row * AW + hi * AD + ch * 8;
        const v4u a = *(const GAS v4u*)op, bq = *(const GAS v4u*)(op + 4 * AD), cq = *(const GAS v4u*)(op + 8 * AD);
        v4u o;
        o.x = pg8::cvt_pk_bf16(w0 * bflo(a.x) + w1 * bflo(bq.x) + w2 * bflo(cq.x), w0 * bfhi(a.x) + w1 * bfhi(bq.x) + w2 * bfhi(cq.x));
        o.y = pg8::cvt_pk_bf16(w0 * bflo(a.y) + w1 * bflo(bq.y) + w2 * bflo(cq.y), w0 * bfhi(a.y) + w1 * bfhi(bq.y) + w2 * bfhi(cq.y));
        o.z = pg8::cvt_pk_bf16(w0 * bflo(a.z) + w1 * bflo(bq.z) + w2 * bflo(cq.z), w0 * bfhi(a.z) + w1 * bfhi(bq.z) + w2 * bfhi(cq.z));
        o.w = pg8::cvt_pk_bf16(w0 * bflo(a.w) + w1 * bflo(bq.w) + w2 * bflo(cq.w), w0 * bfhi(a.w) + w1 * bfhi(bq.w) + w2 * bfhi(cq.w));
        *(GAS v4u*)(YB + pg8::tofs(row, hi * AD + ch * 8, AOW)) = o; }
}
struct Args { Ptrs p; int ph_lo, ph_hi; };
__global__ void __launch_bounds__(NWAVES * 64, 2) mk_fwd(Args args) {
    extern __shared__ __attribute__((aligned(16))) unsigned char lds[];
    Frame F;
    F.lds = (LAS unsigned char*)lds;
    F.MISC = (volatile LAS unsigned*)(F.lds + MISC_OFF);
    F.tid = threadIdx.x; F.lane = F.tid & 63; F.wave = __builtin_amdgcn_readfirstlane(F.tid >> 6);
    F.G = gridDim.x; { const int bx = blockIdx.x; F.vcu = (F.G % 8 == 0) ? (bx % 8) * (F.G / 8) + bx / 8 : bx; }
    unsigned char* ws = args.p.ws;
    F.ctl = (gu32*)(ws + WS_CTL);
    for (int u = F.tid; u < (LDS_BYTES - LDSCTL_OFF) / 4; u += NWAVES * 64) ((LAS unsigned*)(F.lds + LDSCTL_OFF))[u] = 0u;
    __syncthreads();
#if MK_PER_PHASE
#define GRID_BAR() do { } while (0)
#else
    XcdBarrier bar = xcd_barrier_post((unsigned*)(F.ctl + CW_BAR), F.MISC + 8);
#define GRID_BAR() xcd_barrier(bar)
#endif
    const int lo = args.ph_lo, hi = args.ph_hi;
#define IN(k) (lo <= (k) && (k) < hi)
#define REPEAT(k) _Pragma("unroll") for (int rep_ = 0; rep_ < ((MK_REPEAT_PHASE == (k)) ? 2 : 1); ++rep_)
#define SEAM(k) do { if (IN(k) && IN((k) + 1)) GRID_BAR(); } while (0)
    const float* x = args.p.in[0]; float* out = args.p.out;
    bf16* XB = (bf16*)(ws + WS_XB); bf16* HB = (bf16*)(ws + WS_H); bf16* PB = (bf16*)(ws + WS_P); bf16* YR = (bf16*)(ws + WS_YR); bf16* OB = (bf16*)(ws + WS_OB); bf16* YB = (bf16*)(ws + WS_YB);
    bf16* MG = (bf16*)(ws + WS_MG); bf16* TB = (bf16*)(ws + WS_T); float* rstd = (float*)(ws + WS_RSTD); float* part = (float*)(ws + WS_PART); float* lse = (float*)(ws + WS_LSE);
    const float* ropec = (const float*)(ws + WS_ROPEC); const float* ropes = (const float*)(ws + WS_ROPES);
    bf16* RQKV = (bf16*)(ws + WS_RQKV); bf16* AQKV = (bf16*)(ws + WS_AQKV);
    (void)OB; (void)lse;

    if (IN(0)) REPEAT(0) { p0_prologue(F, args.p); } SEAM(0);
    if (IN(1)) REPEAT(1) { pg8::Gemm g{XB, (const bf16*)(ws + WS_WGU1), M, NGU, DM}; pg8::StaticOrder S; S.init(M, NGU, F.G, (int)blockIdx.x);
        pg8::EpiSwiGLU E{HB, DFF, rstd};
        pg8::gemm_phase<pg8::EpiSwiGLU, pg8::StaticOrder, true, true>(F.lds + RING_OFF, g, S, E);
        if (rep_ == 0) tail_convert<1>(F, args.p, ((M / 256) * (NGU / 256)) % F.G); } SEAM(1);
    if (IN(2)) REPEAT(2) { pg8::Gemm g{HB, (const bf16*)(ws + WS_WD1), M, DM, DFF}; pg8::PanelOrder S; S.init(M, DM, F.G, (int)blockIdx.x);
        pg8::EpiResid<false> E{x, nullptr, XB, part, DM, 0.5f};
        pg8::gemm_phase<pg8::EpiResid<false>, pg8::PanelOrder, true, true>(F.lds + RING_OFF, g, S, E); } SEAM(2);
#if MK_NULL_PROBE == 2
    if (IN(2)) { pg8::Gemm g{HB, (const bf16*)(ws + WS_WD1), M, DM, DFF}; pg8::PanelOrder S; S.init(M, DM, F.G, (int)blockIdx.x);
        pg8::EpiNull E{(float*)TB};
        pg8::gemm_phase<pg8::EpiNull, pg8::StaticOrder, true, true>(F.lds + RING_OFF, g, S, E); GRID_BAR(); }
#elif MK_NULL_PROBE == 5
    if (IN(2)) { const unsigned long long t0 = __builtin_amdgcn_s_memrealtime(); while (__builtin_amdgcn_s_memrealtime() - t0 < 30000ull) __builtin_amdgcn_s_sleep(64); GRID_BAR(); }
#elif MK_NULL_PROBE == 4
    if (IN(2)) { pg8::Gemm g{(const bf16*)(ws + WS_T + 64 * MiB), (const bf16*)(ws + WS_T + 68 * MiB), M, NGU, DM}; pg8::SameUnitOrder S;
        pg8::EpiNull E{(float*)TB};
        pg8::gemm_phase<pg8::EpiNull, pg8::SameUnitOrder, true, true>(F.lds + RING_OFF, g, S, E); GRID_BAR(); }
#elif MK_NULL_PROBE == 3
    if (IN(2)) { pg8::Gemm g{XB, (const bf16*)(ws + WS_WGU1), M, NGU, DM}; pg8::SameUnitOrder S;
        pg8::EpiNull E{(float*)TB};
        pg8::gemm_phase<pg8::EpiNull, pg8::SameUnitOrder, true, true>(F.lds + RING_OFF, g, S, E); GRID_BAR(); }
#elif MK_NULL_PROBE == 1
    if (IN(2)) { pg8::Gemm g{XB, (const bf16*)(ws + WS_WGU1), M, NGU, DM}; pg8::StaticOrder S; S.init(M, NGU, F.G, (int)blockIdx.x);
        pg8::EpiNull E{(float*)TB};
        pg8::gemm_phase<pg8::EpiNull, pg8::StaticOrder, true, true>(F.lds + RING_OFF, g, S, E); GRID_BAR(); }
#endif
    if (IN(3)) REPEAT(3) { reduce_rstd(F, part, rstd + M);
#if MK_WIN_LATE
        tail_convert<4>(F, args.p, 0);
#endif
    } SEAM(3);
    if (IN(4)) REPEAT(4) { pg8::Gemm g{XB, (const bf16*)(ws + WS_WIN), M, NIN, DM}; pg8::StaticOrder S; S.init(M, NIN, F.G, (int)blockIdx.x);
        pg8::EpiInProj E{PB, NIN, rstd + M, ropec, ropes, RQKV, AQKV};
        pg8::gemm_phase<pg8::EpiInProj, pg8::StaticOrder, true, true>(F.lds + RING_OFF, g, S, E);
        if (rep_ == 0) tail_convert<2>(F, args.p, ((M / 256) * (NIN / 256)) % F.G); } SEAM(4);
    if (IN(5)) REPEAT(5) {
#if MK_NAIVE_MIX
        naive_attn(F, PB, YB);
#else
        attn_phase(F, AQKV, OB, lse);
#endif
    } SEAM(5);
    if (IN(6)) REPEAT(6) {
#if MK_NAIVE_MIX
        naive_ret(F, PB, YR);
#else
#if MK_REPEAT_PHASE == 66
        _Pragma("unroll 1") for (int rr = 0; rr < 1 + (int)(args.ph_hi > 12); ++rr) ret_phase(F, RQKV, PB, YR);
        attn_merge(F, OB, lse, YB);
#else
        ret_phase(F, RQKV, PB, YR); attn_merge(F, OB, lse, YB);
#endif
#endif
    } SEAM(6);
    if (IN(7)) REPEAT(7) {
        { pg8::Gemm g{YB, (const bf16*)(ws + WS_WOB), M, DM, AOW}; pg8::PanelOrder S; S.init(M, DM, F.G, (int)blockIdx.x);
          pg8::EpiGateB E{PB + C_UB, NIN, TB, DM};
          pg8::gemm_phase<pg8::EpiGateB, pg8::PanelOrder, true, true>(F.lds + RING_OFF, g, S, E); }
        { pg8::Gemm g{YR, (const bf16*)(ws + WS_WOA), M, DM, RW}; pg8::PanelOrder S; S.init(M, DM, F.G, (int)blockIdx.x);
          pg8::EpiGateA E{PB + C_UA, NIN, TB, DM, MG, DM};
          pg8::gemm_phase<pg8::EpiGateA, pg8::PanelOrder, true, true>(F.lds + RING_OFF, g, S, E); }
    } SEAM(7);
    if (IN(8)) REPEAT(8) { pg8::Gemm g{MG, (const bf16*)(ws + WS_WO), M, DM, DM}; pg8::PanelOrder S; S.init(M, DM, F.G, (int)blockIdx.x);
        pg8::EpiResid<true> E{XB, nullptr, XB, part, DM, 1.0f};
        pg8::gemm_phase<pg8::EpiResid<true>, pg8::PanelOrder, true, true>(F.lds + RING_OFF, g, S, E); } SEAM(8);
    if (IN(9)) REPEAT(9) { reduce_rstd(F, part, rstd + 2 * M); } SEAM(9);
    if (IN(10)) REPEAT(10) { pg8::Gemm g{XB, (const bf16*)(ws + WS_WGU2), M, NGU, DM}; pg8::StaticOrder S; S.init(M, NGU, F.G, (int)blockIdx.x);
        pg8::EpiSwiGLU E{HB, DFF, rstd + 2 * M};
        pg8::gemm_phase<pg8::EpiSwiGLU, pg8::StaticOrder, true, true>(F.lds + RING_OFF, g, S, E);
        if (rep_ == 0) tail_convert<3>(F, args.p, ((M / 256) * (NGU / 256)) % F.G); } SEAM(10);
    if (IN(11)) REPEAT(11) { pg8::Gemm g{HB, (const bf16*)(ws + WS_WD2), M, DM, DFF}; pg8::PanelOrder S; S.init(M, DM, F.G, (int)blockIdx.x);
        pg8::EpiResid<true> E{XB, out, nullptr, part, DM, 0.5f};
        pg8::gemm_phase<pg8::EpiResid<true>, pg8::PanelOrder, true, true>(F.lds + RING_OFF, g, S, E); } SEAM(11);
    if (IN(12)) REPEAT(12) { final_norm(F, out, part, args.p.in[14]); }
#undef IN
#undef SEAM
}

extern "C" void kernel_launch(void* const* d_in, const int* in_sizes, int n_in, void* d_out, int out_size, void* d_ws, size_t ws_size, hipStream_t stream) {
    static int grid = 0;
    if (grid == 0) {
        if (n_in != 15 || in_sizes[0] != M * DM || out_size != M * DM || ws_size < WS_END) { fprintf(stderr, "kernel_launch: unexpected shapes / workspace (n_in %d, in0 %d, out %d, ws %zu, need %zu); nothing launched\n", n_in, n_in > 0 ? in_sizes[0] : -1, out_size, ws_size, (size_t)WS_END); grid = -1; return; }
        int dev = 0, cus = 0, per_cu = 0;
        if (hipGetDevice(&dev) != hipSuccess || hipDeviceGetAttribute(&cus, hipDeviceAttributeMultiprocessorCount, dev) != hipSuccess) { grid = -1; return; }
        if (hipFuncSetAttribute((const void*)mk_fwd, hipFuncAttributeMaxDynamicSharedMemorySize, LDS_BYTES) != hipSuccess) { fprintf(stderr, "kernel_launch: hipFuncSetAttribute failed\n"); grid = -1; return; }
        if (hipOccupancyMaxActiveBlocksPerMultiprocessor(&per_cu, (const void*)mk_fwd, NWAVES * 64, LDS_BYTES) != hipSuccess || per_cu < 1)
            fprintf(stderr, "kernel_launch: note: occupancy query reports %d workgroups per CU\n", per_cu);
        (void)hipGetLastError();
        grid = cus;
    }
    if (grid < 0) return;
    if (hipMemsetAsync((char*)d_ws + WS_CTL, 0, CTL_ZERO_BYTES, stream) != hipSuccess) { fprintf(stderr, "kernel_launch: hipMemsetAsync failed\n"); return; }
#if MK_NULL_PROBE == 4
    (void)hipMemsetAsync((char*)d_ws + WS_T + 64 * MiB, 0, 8 * MiB, stream);
#endif
    Args a{};
    for (int i = 0; i < 15; ++i) a.p.in[i] = (const float*)d_in[i];
    a.p.out = (float*)d_out; a.p.ws = (unsigned char*)d_ws;
#if MK_PER_PHASE
    for (int li = 0; li < N_PHASES; ++li) { a.ph_lo = li; a.ph_hi = li + 1;
        hipLaunchKernelGGL(mk_fwd, dim3(grid), dim3(NWAVES * 64), LDS_BYTES, stream, a);
        const hipError_t le = hipPeekAtLastError(); if (le != hipSuccess) { fprintf(stderr, "kernel_launch: launch %d failed: %s\n", li, hipGetErrorName(le)); break; } }
#else
    a.ph_lo = 0; a.ph_hi = N_PHASES;
    hipLaunchKernelGGL(mk_fwd, dim3(grid), dim3(NWAVES * 64), LDS_BYTES, stream, a);
    const hipError_t le = hipPeekAtLastError(); if (le != hipSuccess) fprintf(stderr, "kernel_launch: launch failed: %s\n", hipGetErrorName(le));
#endif
}
```
